# Optimizing an MI355X kernel written in HIP

```python
import math
import jax, jax.numpy as jnp
from jax import lax
import numpy as np

D_MODEL = 2048
BATCH = 8
SEQ = 2048
DEPTH = 2
DEC_BATCH = 16
DEC_SEQ = 16
PAST_LEN = 2048

CHUNK = 64
QBLOCK = 128
PLE_DIM = 256
MIX_WIDTH = D_MODEL
ATTN_WIDTH = MIX_WIDTH // 2
SSM_WIDTH = MIX_WIDTH - ATTN_WIDTH
HEAD_DIM = 128
N_HEADS = ATTN_WIDTH // HEAD_DIM
SSM_GROUP = 16
N_SSM_GROUPS = SSM_WIDTH // SSM_GROUP
SSM_STATE = 64
D_FF = ((8 * D_MODEL + 3 * 256 - 1) // (3 * 256)) * 256
IN_COLS = 3 * ATTN_WIDTH + N_HEADS + SSM_WIDTH
EPS = 1e-6
NEG_INF = -1e30

kernel_name = 'hybrid_fox_s5_stream_step'


def rms_norm(x, g):
    xf = x.astype(jnp.float32)
    y = xf * lax.rsqrt(jnp.mean(xf * xf, axis=-1, keepdims=True) + EPS)
    return (y * g.astype(jnp.float32)).astype(x.dtype)


def fox_attend(q, k, v, cq, ck, pos_q, pos_k):
    s = jnp.einsum('bqhd,bkhd->bhqk', q, k, preferred_element_type=jnp.float32) * (HEAD_DIM ** -0.5)
    bias = cq.astype(jnp.float32).transpose(0, 2, 1)[..., :, None] - ck.astype(jnp.float32).transpose(0, 2, 1)[..., None, :]
    s = jnp.where(pos_k[None, :] <= pos_q[:, None], s + bias, NEG_INF)
    p = jax.nn.softmax(s, axis=-1)
    return jnp.einsum('bhqk,bkhd->bqhd', p.astype(v.dtype), v)


def fox_prompt(q, k, v, c):
    b, t, h, d = q.shape
    nb = t // QBLOCK
    pos = jnp.arange(t)
    qb = q.reshape(b, nb, QBLOCK, h, d).transpose(1, 0, 2, 3, 4)
    cb = c.reshape(b, nb, QBLOCK, h).transpose(1, 0, 2, 3)
    pb = pos.reshape(nb, QBLOCK)

    def one_block(args):
        qi, ci, pi = args
        return fox_attend(qi, k, v, ci, c, pi, pos)

    out = lax.map(one_block, (qb, cb, pb))
    return out.transpose(1, 0, 2, 3, 4).reshape(b, t, h * d)


def s5_mixer(u, x0_re, x0_im, a_re, a_im, log_dt, b_re, b_im, c_re, c_im, d_skip, w_glu, b_glu):
    f32 = jnp.float32
    bsz, t, _ = u.shape
    ug = u.astype(f32).reshape(bsz, t, N_SSM_GROUPS, SSM_GROUP)
    ar, ai = a_re.astype(f32), a_im.astype(f32)
    dt = jnp.exp(log_dt.astype(f32))[:, None]
    mag = jnp.exp(ar * dt)
    ang = ai * dt
    abar_re, abar_im = mag * jnp.cos(ang), mag * jnp.sin(ang)
    den = ar * ar + ai * ai
    nr, ni = abar_re - 1.0, abar_im
    coef_re = (nr * ar + ni * ai) / den
    coef_im = (ni * ar - nr * ai) / den
    br, bi = b_re.astype(f32), b_im.astype(f32)
    bbar_re = coef_re[..., None] * br - coef_im[..., None] * bi
    bbar_im = coef_re[..., None] * bi + coef_im[..., None] * br
    bu_re = jnp.einsum('gpc,btgc->btgp', bbar_re, ug)
    bu_im = jnp.einsum('gpc,btgc->btgp', bbar_im, ug)
    x0r, x0i = x0_re.astype(f32), x0_im.astype(f32)
    bu_re = bu_re.at[:, 0].add(abar_re * x0r - abar_im * x0i)
    bu_im = bu_im.at[:, 0].add(abar_re * x0i + abar_im * x0r)
    a_r = jnp.broadcast_to(abar_re, bu_re.shape)
    a_i = jnp.broadcast_to(abar_im, bu_re.shape)

    def combine(e1, e2):
        a1r, a1i, b1r, b1i = e1
        a2r, a2i, b2r, b2i = e2
        return (a2r * a1r - a2i * a1i,
                a2r * a1i + a2i * a1r,
                a2r * b1r - a2i * b1i + b2r,
                a2r * b1i + a2i * b1r + b2i)

    _, _, xr, xi = lax.associative_scan(combine, (a_r, a_i, bu_re, bu_im), axis=1)
    y = (jnp.einsum('gcp,btgp->btgc', c_re.astype(f32), xr)
         - jnp.einsum('gcp,btgp->btgc', c_im.astype(f32), xi)
         + d_skip.astype(f32).reshape(N_SSM_GROUPS, SSM_GROUP) * ug)
    g = jax.nn.gelu(y.reshape(bsz, t, SSM_WIDTH))
    out = g * jax.nn.sigmoid(g @ w_glu.astype(f32) + b_glu.astype(f32))
    return out.astype(u.dtype), xr[:, -1], xi[:, -1]


def trunk_layer(x, p_i, k_past, v_past, logf_past, s_re, s_im,
                g_mix, w_in, b_f, g_q, g_k, a_re, a_im, log_dt, b_re, b_im, c_re, c_im,
                d_skip, w_glu, b_glu, g_attn_out, g_ssm_out, w_out, g_ffn, w_gate, w_up,
                w_down, g_ple, w_ple_gate, w_ple_proj):
    bsz, t, _ = x.shape
    a = rms_norm(x, g_mix)
    proj = a @ w_in
    q = proj[..., :ATTN_WIDTH].reshape(bsz, t, N_HEADS, HEAD_DIM)
    k = proj[..., ATTN_WIDTH:2 * ATTN_WIDTH].reshape(bsz, t, N_HEADS, HEAD_DIM)
    v = proj[..., 2 * ATTN_WIDTH:3 * ATTN_WIDTH].reshape(bsz, t, N_HEADS, HEAD_DIM)
    f_logit = proj[..., 3 * ATTN_WIDTH:3 * ATTN_WIDTH + N_HEADS]
    u = proj[..., 3 * ATTN_WIDTH + N_HEADS:]
    q = rms_norm(q, g_q)
    k = rms_norm(k, g_k)
    logf = jax.nn.log_sigmoid((f_logit + b_f).astype(jnp.float32))
    if k_past is None:
        c = jnp.cumsum(logf, axis=1)
        attn = fox_prompt(q, k, v, c)
    else:
        past = k_past.shape[1]
        k_all = jnp.concatenate([k_past.astype(k.dtype), k], axis=1)
        v_all = jnp.concatenate([v_past.astype(v.dtype), v], axis=1)
        c_all = jnp.cumsum(jnp.concatenate([logf_past.astype(jnp.float32), logf], axis=1), axis=1)
        pos_k = jnp.arange(past + t)
        pos_q = past + jnp.arange(t)
        attn = fox_attend(q, k_all, v_all, c_all[:, past:], c_all, pos_q, pos_k).reshape(bsz, t, ATTN_WIDTH)
    ssm, s_re_new, s_im_new = s5_mixer(u, s_re, s_im, a_re, a_im, log_dt, b_re, b_im,
                                       c_re, c_im, d_skip, w_glu, b_glu)
    merged = jnp.concatenate([rms_norm(attn, g_attn_out), rms_norm(ssm, g_ssm_out)], axis=-1)
    h = x + merged @ w_out
    f = rms_norm(h, g_ffn)
    h = h + (jax.nn.silu(f @ w_gate) * (f @ w_up)) @ w_down
    gate = jax.nn.sigmoid(rms_norm(h, g_ple) @ w_ple_gate)
    h = h + gate * (p_i @ w_ple_proj)
    return h, k, v, logf, s_re_new, s_im_new


def setup_inputs(seed: int = 0) -> dict:
    key = jax.random.key(seed)
    ks = iter(jax.random.split(key, 48))
    f32 = jnp.float32

    def nrm(shape, scale):
        return scale * jax.random.normal(next(ks), shape, f32)

    def gain(shape):
        return 1.0 + nrm(shape, 0.02)

    L, G, P = DEPTH, N_SSM_GROUPS, SSM_STATE
    return {
        'x_prompt': nrm((BATCH, SEQ, D_MODEL), 1.0),
        'x_sample': nrm((DEC_BATCH, DEC_SEQ, D_MODEL), 1.0),
        'cache_k': nrm((L, DEC_BATCH, PAST_LEN, N_HEADS, HEAD_DIM), 1.0),
        'cache_v': nrm((L, DEC_BATCH, PAST_LEN, N_HEADS, HEAD_DIM), 1.0),
        'cache_logf': jax.nn.log_sigmoid(3.0 + nrm((L, DEC_BATCH, PAST_LEN, N_HEADS), 1.0)),
        'state_ssm_re': nrm((L, DEC_BATCH, G, P), 0.1),
        'state_ssm_im': nrm((L, DEC_BATCH, G, P), 0.1),
        'p_prompt': nrm((L, BATCH, SEQ, PLE_DIM), 1.0),
        'p_sample': nrm((L, DEC_BATCH, DEC_SEQ, PLE_DIM), 1.0),
        'g_mix': gain((L, D_MODEL)),
        'w_in': nrm((L, D_MODEL, IN_COLS), D_MODEL ** -0.5),
        'b_f': 3.0 + nrm((L, N_HEADS), 0.5),
        'g_q': gain((L, HEAD_DIM)),
        'g_k': gain((L, HEAD_DIM)),
        'a_re': -0.5 + nrm((L, G, P), 0.01),
        'a_im': math.pi * jnp.arange(P, dtype=f32)[None, None, :] + nrm((L, G, P), 0.01),
        'log_dt': jax.random.uniform(next(ks), (L, G), f32, math.log(1e-3), math.log(1e-1)),
        'b_re': nrm((L, G, P, SSM_GROUP), (2 * SSM_GROUP) ** -0.5),
        'b_im': nrm((L, G, P, SSM_GROUP), (2 * SSM_GROUP) ** -0.5),
        'c_re': nrm((L, G, SSM_GROUP, P), (2 * P) ** -0.5),
        'c_im': nrm((L, G, SSM_GROUP, P), (2 * P) ** -0.5),
        'd_skip': nrm((L, SSM_WIDTH), 1.0),
        'w_glu': nrm((L, SSM_WIDTH, SSM_WIDTH), SSM_WIDTH ** -0.5),
        'b_glu': nrm((L, SSM_WIDTH), 0.02),
        'g_attn_out': gain((L, ATTN_WIDTH)),
        'g_ssm_out': gain((L, SSM_WIDTH)),
        'w_out': nrm((L, MIX_WIDTH, D_MODEL), MIX_WIDTH ** -0.5),
        'g_ffn': gain((L, D_MODEL)),
        'w_gate': nrm((L, D_MODEL, D_FF), D_MODEL ** -0.5),
        'w_up': nrm((L, D_MODEL, D_FF), D_MODEL ** -0.5),
        'w_down': nrm((L, D_FF, D_MODEL), D_FF ** -0.5),
        'g_ple': gain((L, D_MODEL)),
        'w_ple_gate': nrm((L, D_MODEL, D_MODEL), D_MODEL ** -0.5),
        'w_ple_proj': nrm((L, PLE_DIM, D_MODEL), PLE_DIM ** -0.5),
    }


def reference(x_prompt, x_sample, cache_k, cache_v, cache_logf, state_ssm_re, state_ssm_im,
              p_prompt, p_sample, g_mix, w_in, b_f, g_q, g_k, a_re, a_im, log_dt, b_re, b_im,
              c_re, c_im, d_skip, w_glu, b_glu, g_attn_out, g_ssm_out, w_out, g_ffn, w_gate,
              w_up, w_down, g_ple, w_ple_gate, w_ple_proj):
    assert x_sample.shape[1] <= CHUNK
    zero_state = jnp.zeros((x_prompt.shape[0], N_SSM_GROUPS, SSM_STATE), jnp.float32)
    hp, hs = x_prompt, x_sample
    kp, vp, fp, srp, sip = [], [], [], [], []
    ksm, vsm, fsm, srs, sis = [], [], [], [], []
    for i in range(DEPTH):
        w = (g_mix[i], w_in[i], b_f[i], g_q[i], g_k[i], a_re[i], a_im[i], log_dt[i], b_re[i],
             b_im[i], c_re[i], c_im[i], d_skip[i], w_glu[i], b_glu[i], g_attn_out[i],
             g_ssm_out[i], w_out[i], g_ffn[i], w_gate[i], w_up[i], w_down[i], g_ple[i],
             w_ple_gate[i], w_ple_proj[i])
        hp, k1, v1, f1, r1, m1 = trunk_layer(hp, p_prompt[i], None, None, None,
                                             zero_state, zero_state, *w)
        hs, k2, v2, f2, r2, m2 = trunk_layer(hs, p_sample[i], cache_k[i], cache_v[i], cache_logf[i],
                                             state_ssm_re[i], state_ssm_im[i], *w)
        kp.append(k1); vp.append(v1); fp.append(f1); srp.append(r1); sip.append(m1)
        ksm.append(k2); vsm.append(v2); fsm.append(f2); srs.append(r2); sis.append(m2)
    y_prompt, y_sample = hp, hs
    k_prompt, v_prompt, logf_prompt = jnp.stack(kp), jnp.stack(vp), jnp.stack(fp)
    ssm_re_prompt, ssm_im_prompt = jnp.stack(srp), jnp.stack(sip)
    k_sample, v_sample, logf_sample = jnp.stack(ksm), jnp.stack(vsm), jnp.stack(fsm)
    ssm_re_sample, ssm_im_sample = jnp.stack(srs), jnp.stack(sis)
    return (y_prompt, y_sample, k_prompt, v_prompt, logf_prompt, ssm_re_prompt, ssm_im_prompt,
            k_sample, v_sample, logf_sample, ssm_re_sample, ssm_im_sample)
```

```cpp
#include <hip/hip_runtime.h>
#include <cstdio>
#include <cstdint>

#define LAS __attribute__((address_space(3)))
#define GAS __attribute__((address_space(1)))
typedef unsigned short bf16;
typedef short bf16x8 __attribute__((ext_vector_type(8)));
typedef short s16x4 __attribute__((ext_vector_type(4)));
typedef float f32x4 __attribute__((ext_vector_type(4)));
typedef float f32x2 __attribute__((ext_vector_type(2)));
typedef float f32x16 __attribute__((ext_vector_type(16)));
typedef unsigned u32x4 __attribute__((ext_vector_type(4)));
typedef unsigned u32x2 __attribute__((ext_vector_type(2)));

constexpr int D = 2048, MP = 16384, MS = 256, MT = MP + MS, NH = 8, HD = 128, AW = 1024, SW = 1024, NG = 64, NP = 64, DFF = 5632, PLE = 256, INC = 4104;
constexpr int NL = 2, PAST = 2048, SEQ = 2048, DSEQ = 16, NBAT = 8, DBAT = 16, NGU = 2 * DFF;
constexpr float EPS = 1e-6f;
constexpr float QSCALE = 0.08838834764831845f * 1.4426950408889634f;
constexpr float LOG2E = 1.4426950408889634f;
constexpr int SS = 64;

constexpr size_t O_YP = 0, O_YS = O_YP + (size_t)MP * D, O_KP = O_YS + (size_t)MS * D, O_VP = O_KP + (size_t)NL * MP * AW, O_LFP = O_VP + (size_t)NL * MP * AW,
                 O_SRP = O_LFP + (size_t)NL * MP * NH, O_SIP = O_SRP + (size_t)NL * NBAT * NG * NP, O_KS = O_SIP + (size_t)NL * NBAT * NG * NP, O_VS = O_KS + (size_t)NL * MS * AW,
                 O_LFS = O_VS + (size_t)NL * MS * AW, O_SRS = O_LFS + (size_t)NL * MS * NH, O_SIS = O_SRS + (size_t)NL * DBAT * NG * NP, O_END = O_SIS + (size_t)NL * DBAT * NG * NP;

constexpr size_t al256(size_t x) { return (x + 255) & ~(size_t)255; }
constexpr size_t WS_CTL = 0, CTL_BYTES = 1 << 20;
constexpr size_t W_IN = 0, W_F = W_IN + (size_t)4096 * D * 2, W_GLU = W_F + (size_t)32 * D * 2, W_OUT = W_GLU + (size_t)SW * SW * 2, W_GU = W_OUT + (size_t)D * D * 2,
                 W_DOWN = W_GU + (size_t)NGU * D * 2, W_PLE = W_DOWN + (size_t)D * DFF * 2, W_PP = W_PLE + (size_t)D * D * 2, W_ABR = W_PP + (size_t)D * PLE * 2,
                 W_ABI = W_ABR + (size_t)NG * NP * 4, W_BCAT = W_ABI + (size_t)NG * NP * 4, W_CCAT = W_BCAT + (size_t)NG * 128 * 16 * 2, W_LAYER = al256(W_CCAT + (size_t)NG * 16 * 128 * 2);
constexpr size_t WS_W = CTL_BYTES;
constexpr size_t WS_XB = WS_W + NL * W_LAYER;
constexpr size_t WS_HF = WS_XB + (size_t)MT * D * 2;
constexpr size_t WS_HB = WS_HF + (size_t)MT * D * 4;
constexpr size_t WS_PB = WS_HB + (size_t)MT * D * 2;
constexpr size_t WS_PP = WS_PB + (size_t)NL * MT * PLE * 2;
constexpr size_t WS_ST = WS_PP + (size_t)MT * D * 2;
constexpr size_t ST_BYTES = (size_t)MT * SS * 4;
constexpr size_t WS_CUM = WS_ST + 5 * ST_BYTES;
constexpr size_t WS_OV = al256(WS_CUM + (size_t)MP * NH * 4 + (size_t)DBAT * (PAST + DSEQ) * NH * 4);
constexpr size_t WS_QB = WS_OV, WS_KB = WS_QB + (size_t)MT * AW * 2, WS_VB = WS_KB + (size_t)MT * AW * 2, WS_UB = WS_VB + (size_t)MT * AW * 2,
                 WS_GS = WS_UB + (size_t)MT * SW * 2, WS_MG = WS_GS + (size_t)MT * SW * 2, WS_OV_END1 = WS_MG + (size_t)MT * D * 2;
constexpr size_t WS_ACT = WS_OV, WS_OV_END2 = WS_ACT + (size_t)MT * DFF * 2;
constexpr size_t WS_END = WS_OV_END1 > WS_OV_END2 ? WS_OV_END1 : WS_OV_END2;

struct Ctx {
    const float* in[34];
    float* out;
    unsigned char* ws;
};

typedef __bf16 bf16x2_t __attribute__((ext_vector_type(2)));
__device__ __forceinline__ unsigned cvtpk(float lo, float hi) { const f32x2 v = {lo, hi}; const bf16x2_t b = __builtin_convertvector(v, bf16x2_t); return __builtin_bit_cast(unsigned, b); }
__device__ __forceinline__ float bf2f(unsigned short b) { return __uint_as_float(((unsigned)b) << 16); }
__device__ __forceinline__ float bflo(unsigned w) { return __uint_as_float(w << 16); }
__device__ __forceinline__ float bfhi(unsigned w) { return __uint_as_float(w & 0xffff0000u); }
__device__ __forceinline__ float wave_sum(float v) {
#pragma unroll
    for (int o = 1; o < 64; o <<= 1) v += __shfl_xor(v, o);
    return v;
}
__device__ __forceinline__ float wave_max(float v) {
#pragma unroll
    for (int o = 1; o < 64; o <<= 1) v = fmaxf(v, __shfl_xor(v, o));
    return v;
}
__device__ __forceinline__ float sigmoidf_(float x) { return __builtin_amdgcn_rcpf(1.0f + __builtin_amdgcn_exp2f(x * -1.4426950408889634f)); }
__device__ __forceinline__ float log_sigmoid_(float z) { return fminf(z, 0.f) - log1pf(expf(-fabsf(z))); }
__device__ __forceinline__ float gelu_tanh_(float y) { const float t = 0.7978845608028654f * (y + 0.044715f * y * y * y); return y * sigmoidf_(2.0f * t); }

struct Lw {
    const bf16 *win, *wf, *wglu, *wout, *wgu, *wdown, *wple, *wpp, *bcat, *ccat; const float *abr, *abi;
};
__device__ __forceinline__ Lw layer_w(const Ctx& c, int l) {
    unsigned char* b = c.ws + WS_W + (size_t)l * W_LAYER; Lw w;
    w.win = (const bf16*)(b + W_IN); w.wf = (const bf16*)(b + W_F); w.wglu = (const bf16*)(b + W_GLU); w.wout = (const bf16*)(b + W_OUT); w.wgu = (const bf16*)(b + W_GU);
    w.wdown = (const bf16*)(b + W_DOWN); w.wple = (const bf16*)(b + W_PLE); w.wpp = (const bf16*)(b + W_PP); w.abr = (const float*)(b + W_ABR); w.abi = (const float*)(b + W_ABI);
    w.bcat = (const bf16*)(b + W_BCAT); w.ccat = (const bf16*)(b + W_CCAT); return w;
}
__device__ __forceinline__ float* stat_ptr(const Ctx& c, int which) { return (float*)(c.ws + WS_ST + (size_t)which * ST_BYTES); }
enum { ST_X = 0, ST_A = 1, ST_S = 2, ST_H = 3, ST_H2 = 4 };
__device__ __forceinline__ float row_rs(const float* st, int row, int ns, float invn) {
    const float* p = st + (size_t)row * SS; float s = 0.f;
    if (ns == 1) s = p[0];
    else for (int i = 0; i < ns; i += 4) { const f32x4 v = *(const f32x4*)(p + i); s += (v.x + v.y) + (v.z + v.w); }
    return rsqrtf(s * invn + EPS);
}

struct TrItem { const float* W; int ldw, src_col0; const float* gain; bf16* WT; int K, dst_row0, k0, nvalid; };
__device__ __forceinline__ void tr_load(const TrItem& t, f32x4 (&v)[8], int lane) {
    const int kr = lane >> 3, n4 = (lane & 7) * 4;
#pragma unroll
    for (int i = 0; i < 8; ++i) v[i] = (n4 < t.nvalid) ? *(const f32x4*)(t.W + (size_t)(t.k0 + 8 * i + kr) * t.ldw + t.src_col0 + n4) : (f32x4){0.f, 0.f, 0.f, 0.f};
}
__device__ __forceinline__ void tr_store(const TrItem& t, const f32x4 (&v)[8], LAS float* scr, int lane) {
    const int kr = lane >> 3, n4 = (lane & 7) * 4;
#pragma unroll
    for (int i = 0; i < 8; ++i) { const int kk = 8 * i + kr; const float gn = t.gain ? t.gain[t.k0 + kk] : 1.0f; LAS float* d = scr + kk * 33 + n4;
        d[0] = v[i].x * gn; d[1] = v[i].y * gn; d[2] = v[i].z * gn; d[3] = v[i].w * gn; }
    asm volatile("s_waitcnt lgkmcnt(0)" ::: "memory");
    const int c = lane & 7;
#pragma unroll
    for (int j = 0; j < 4; ++j) { const int n = (lane >> 3) + 8 * j; const LAS float* s = scr + (8 * c) * 33 + n;
        u32x4 o; o.x = cvtpk(s[0 * 33], s[1 * 33]); o.y = cvtpk(s[2 * 33], s[3 * 33]); o.z = cvtpk(s[4 * 33], s[5 * 33]); o.w = cvtpk(s[6 * 33], s[7 * 33]);
        *(u32x4*)(t.WT + (size_t)(t.dst_row0 + n) * t.K + t.k0 + 8 * c) = o; }
    asm volatile("s_waitcnt lgkmcnt(0)" ::: "memory");
}
constexpr int I_IN = 32 * 128, I_GU = 32 * 352, I_OUT = 32 * 64, I_GLU = 16 * 32, I_DOWN = 88 * 64, I_PLE = 32 * 64, I_PP = 4 * 64, I_F = 32;
constexpr int I_LAYER = I_IN + I_GU + I_OUT + I_GLU + I_DOWN + I_PLE + I_PP + I_F;
__device__ __forceinline__ TrItem tr_item_of(const Ctx& c, int it) {
    const int l = it / I_LAYER; int r = it % I_LAYER; unsigned char* wb = c.ws + WS_W + (size_t)l * W_LAYER; TrItem t;
    if (r < I_IN) { const int kb = r / 128, nb = r % 128, n0 = 32 * nb;
        t = TrItem{c.in[10] + (size_t)l * D * INC, INC, n0 + (n0 >= 3072 ? 8 : 0), c.in[9] + l * D, (bf16*)(wb + W_IN), D, n0, 64 * kb, 32}; return t; } r -= I_IN;
    if (r < I_GU) { const int kb = r / 352, nb = r % 352, n0 = 32 * nb, pn = n0 >> 8, half = (n0 >> 7) & 1, j0 = n0 & 127;
        t = TrItem{(half ? c.in[29] : c.in[28]) + (size_t)l * D * DFF, DFF, 128 * pn + j0, c.in[27] + l * D, (bf16*)(wb + W_GU), D, n0, 64 * kb, 32}; return t; } r -= I_GU;
    if (r < I_OUT) { const int kb = r / 64, nb = r % 64, k0 = 64 * kb;
        t = TrItem{c.in[26] + (size_t)l * D * D, D, 32 * nb, (k0 < AW) ? (c.in[24] + l * AW) : (c.in[25] + l * SW - AW), (bf16*)(wb + W_OUT), D, 32 * nb, k0, 32}; return t; } r -= I_OUT;
    if (r < I_GLU) { const int kb = r / 32, nb = r % 32;
        t = TrItem{c.in[22] + (size_t)l * SW * SW, SW, 32 * nb, nullptr, (bf16*)(wb + W_GLU), SW, 32 * nb, 64 * kb, 32}; return t; } r -= I_GLU;
    if (r < I_DOWN) { const int kb = r / 64, nb = r % 64;
        t = TrItem{c.in[30] + (size_t)l * DFF * D, D, 32 * nb, nullptr, (bf16*)(wb + W_DOWN), DFF, 32 * nb, 64 * kb, 32}; return t; } r -= I_DOWN;
    if (r < I_PLE) { const int kb = r / 64, nb = r % 64;
        t = TrItem{c.in[32] + (size_t)l * D * D, D, 32 * nb, c.in[31] + l * D, (bf16*)(wb + W_PLE), D, 32 * nb, 64 * kb, 32}; return t; } r -= I_PLE;
    if (r < I_PP) { const int kb = r / 64, nb = r % 64;
        t = TrItem{c.in[33] + (size_t)l * PLE * D, D, 32 * nb, nullptr, (bf16*)(wb + W_PP), PLE, 32 * nb, 64 * kb, 32}; return t; } r -= I_PP;
    t = TrItem{c.in[10] + (size_t)l * D * INC, INC, 3072, c.in[9] + l * D, (bf16*)(wb + W_F), D, 0, 64 * r, 8}; return t;
}

__device__ __forceinline__ void p0_prologue(const Ctx& c, LAS unsigned char* lds, int gw, int ngw, int wave, int lane) {
    LAS float* scr = (LAS float*)(lds + wave * 8448);
    { f32x4 va[8], vb_[8]; int it = gw;
      TrItem ta = tr_item_of(c, it < NL * I_LAYER ? it : 0), tb = ta;
      if (it < NL * I_LAYER) tr_load(ta, va, lane);
      while (it < NL * I_LAYER) {
          const int i1 = it + ngw; if (i1 < NL * I_LAYER) { tb = tr_item_of(c, i1); tr_load(tb, vb_, lane); }
          tr_store(ta, va, scr, lane);
          if (i1 >= NL * I_LAYER) break;
          const int i2 = i1 + ngw; if (i2 < NL * I_LAYER) { ta = tr_item_of(c, i2); tr_load(ta, va, lane); }
          tr_store(tb, vb_, scr, lane);
          it = i2;
      } }
    for (int i = gw * 64 + lane; i < NL * NG * NP; i += ngw * 64) {
        const int l = i / (NG * NP), g = (i / NP) % NG, p = i % NP; unsigned char* wb = c.ws + WS_W + (size_t)l * W_LAYER;
        const float ar = c.in[14][i], ai = c.in[15][i], dt = expf(c.in[16][l * NG + g]);
        const float mag = expf(ar * dt), ang = ai * dt, abr = mag * cosf(ang), abi = mag * sinf(ang), den = ar * ar + ai * ai, nr = abr - 1.0f, ni = abi;
        const float cr = (nr * ar + ni * ai) / den, ci = (ni * ar - nr * ai) / den;
        ((float*)(wb + W_ABR))[g * NP + p] = abr; ((float*)(wb + W_ABI))[g * NP + p] = abi;
        const float* br = c.in[17] + (size_t)i * 16; const float* bi = c.in[18] + (size_t)i * 16;
        bf16* bc = (bf16*)(wb + W_BCAT) + (size_t)g * 128 * 16;
        for (int ch = 0; ch < 16; ch += 2) {
            const float r0 = cr * br[ch] - ci * bi[ch], r1 = cr * br[ch + 1] - ci * bi[ch + 1], i0 = cr * bi[ch] + ci * br[ch], i1 = cr * bi[ch + 1] + ci * br[ch + 1];
            *(unsigned*)(bc + p * 16 + ch) = cvtpk(r0, r1); *(unsigned*)(bc + (64 + p) * 16 + ch) = cvtpk(i0, i1); }
        bf16* cc = (bf16*)(wb + W_CCAT) + (size_t)g * 16 * 128;
        const float* cre = c.in[19] + ((size_t)l * NG + g) * 16 * NP; const float* cim = c.in[20] + ((size_t)l * NG + g) * 16 * NP;
        for (int ch = 0; ch < 16; ++ch) { cc[ch * 128 + p] = (bf16)(cvtpk(cre[ch * NP + p], 0.f) & 0xffff); cc[ch * 128 + 64 + p] = (bf16)(cvtpk(-cim[ch * NP + p], 0.f) & 0xffff); }
    }
    bf16* xb = (bf16*)(c.ws + WS_XB); float* stx = stat_ptr(c, ST_X);
    for (int row0 = 2 * gw; row0 < MT; row0 += 2 * ngw) {
        f32x4 v[2][8];
#pragma unroll
        for (int q = 0; q < 2; ++q) { const int row = row0 + q; const float* xr = row < MP ? c.in[0] + (size_t)row * D : c.in[1] + (size_t)(row - MP) * D;
#pragma unroll
            for (int j = 0; j < 8; ++j) v[q][j] = *(const f32x4*)(xr + j * 256 + lane * 4); }
#pragma unroll
        for (int q = 0; q < 2; ++q) { const int row = row0 + q; float s = 0.f;
#pragma unroll
            for (int j = 0; j < 8; ++j) { const f32x4 w = v[q][j]; s += (w.x * w.x + w.y * w.y) + (w.z * w.z + w.w * w.w);
                u32x2 o; o.x = cvtpk(w.x, w.y); o.y = cvtpk(w.z, w.w); *(u32x2*)(xb + (size_t)row * D + j * 256 + lane * 4) = o; }
            s = wave_sum(s); if (lane == 0) stx[(size_t)row * SS] = s; }
    }
    bf16* pb = (bf16*)(c.ws + WS_PB);
    for (int i0 = 8 * gw; i0 < NL * MT; i0 += 8 * ngw) {
        f32x4 v[8];
#pragma unroll
        for (int q = 0; q < 8; ++q) { const int i = i0 + q, l = i / MT, row = i % MT;
            const float* pr = row < MP ? c.in[7] + ((size_t)l * MP + row) * PLE : c.in[8] + ((size_t)l * MS + (row - MP)) * PLE; v[q] = *(const f32x4*)(pr + lane * 4); }
#pragma unroll
        for (int q = 0; q < 8; ++q) { u32x2 o; o.x = cvtpk(v[q].x, v[q].y); o.y = cvtpk(v[q].z, v[q].w); *(u32x2*)(pb + (size_t)(i0 + q) * PLE + lane * 4) = o; } }
}

constexpr size_t UB_S_OFF = (size_t)NBAT * NG * SEQ * 16;
__device__ __forceinline__ void st_bf4(bf16* p, f32x4 v) { u32x2 o; o.x = cvtpk(v.x, v.y); o.y = cvtpk(v.z, v.w); *(u32x2*)p = o; }
__device__ __forceinline__ f32x4 ld_bf4(const bf16* p) { const u32x2 w = *(const u32x2*)p; return (f32x4){bflo(w.x), bfhi(w.x), bflo(w.y), bfhi(w.y)}; }
__device__ __forceinline__ float sumsq4(f32x4 v) { return (v.x * v.x + v.y * v.y) + (v.z * v.z + v.w * v.w); }

struct EpiIn {
    static constexpr bool MID = false, STATS = false, HAS_RS = true, QKN = true;
    const float* stx; int nsP, nsS; float* st;
    bf16 *qb, *vb, *ub; float *kP, *kS, *vP, *vS; bf16* kb; const float *gq, *gk;
    __device__ __forceinline__ float row_begin(int row) const { return row_rs(stx, row, row < MP ? nsP : nsS, 1.0f / D); }
    __device__ __forceinline__ float mid_scale(int) const { return 1.f; }
    __device__ __forceinline__ float apply(float rs, int row, int col, f32x4 v) const {
        v = v * rs;
        if (col < 1024) { st_bf4(qb + (size_t)row * AW + col, v); }
        else if (col < 2048) { float* k = row < MP ? kP + (size_t)row * AW : kS + (size_t)(row - MP) * AW; *(f32x4*)(k + (col - 1024)) = v; }
        else if (col < 3072) { float* vo = row < MP ? vP + (size_t)row * AW : vS + (size_t)(row - MP) * AW; *(f32x4*)(vo + (col - 2048)) = v; st_bf4(vb + (size_t)row * AW + (col - 2048), v); }
        else { const int c = col - 3072, g = c >> 4, ch = c & 15; const int r = row - MP;
            const size_t idx = row < MP ? (((size_t)(row >> 11) * NG + g) * SEQ + (row & 2047)) * 16 + ch : UB_S_OFF + (((size_t)(r >> 4) * NG + g) * DSEQ + (r & 15)) * 16 + ch;
            st_bf4(ub + idx, v); }
        return 0.f;
    }
};
struct EpiF {
    static constexpr bool MID = false, STATS = false, HAS_RS = true, QKN = false;
    const float* stx; int nsP, nsS; float* st;
    const float* bf; float *lfP, *lfS;
    __device__ __forceinline__ float row_begin(int row) const { return row_rs(stx, row, row < MP ? nsP : nsS, 1.0f / D); }
    __device__ __forceinline__ float mid_scale(int) const { return 1.f; }
    __device__ __forceinline__ float apply(float rs, int row, int col, f32x4 v) const {
        if (col < 8) { f32x4 o;
#pragma unroll
            for (int e = 0; e < 4; ++e) o[e] = log_sigmoid_(rs * v[e] + bf[col + e]);
            float* p = row < MP ? lfP + (size_t)row * NH : lfS + (size_t)(row - MP) * NH; *(f32x4*)(p + col) = o; }
        return 0.f;
    }
};
struct EpiGlu {
    static constexpr bool MID = false, STATS = true, HAS_RS = false, QKN = false;
    float* st; const float* bglu; const bf16* gs; bf16* mg;
    __device__ __forceinline__ float row_begin(int) const { return 1.f; }
    __device__ __forceinline__ float mid_scale(int) const { return 1.f; }
    __device__ __forceinline__ float apply(float, int row, int col, f32x4 v) const {
        const f32x4 b = *(const f32x4*)(bglu + col); const f32x4 g = ld_bf4(gs + (size_t)row * SW + col); f32x4 s;
#pragma unroll
        for (int e = 0; e < 4; ++e) s[e] = g[e] * sigmoidf_(v[e] + b[e]);
        st_bf4(mg + (size_t)row * D + AW + col, s); return sumsq4(s);
    }
};
struct EpiOut {
    static constexpr bool MID = true, STATS = true, HAS_RS = true, QKN = false;
    float* st; const float *sta, *sts; int nsS_P, nsS_S; const float *xinP, *xinS; const bf16* xinB; bf16* hb; const LAS float* mid_tab;
    __device__ __forceinline__ float r_s(int row) const { return row_rs(sts, row, row < MP ? nsS_P : nsS_S, 1.0f / SW); }
    __device__ __forceinline__ float row_begin(int row) const { return r_s(row); }
    __device__ __forceinline__ float mid_scale(int row) const { return row_rs(sta, row, NH, 1.0f / AW) / r_s(row); }
    __device__ __forceinline__ float apply(float rs, int row, int col, f32x4 v) const {
        f32x4 x;
        if (xinB) x = ld_bf4(xinB + (size_t)row * D + col); else { const float* xin = row < MP ? xinP + (size_t)row * D : xinS + (size_t)(row - MP) * D; x = *(const f32x4*)(xin + col); }
        const f32x4 h = x + v * rs;
        st_bf4(hb + (size_t)row * D + col, h); return sumsq4(h);
    }
};
struct EpiGU {
    static constexpr bool MID = false, STATS = false, HAS_RS = true, QKN = false;
    float* st; const float* sth; int nsP, nsS; bf16* act;
    __device__ __forceinline__ float row_begin(int row) const { return row_rs(sth, row, row < MP ? nsP : nsS, 1.0f / D); }
    __device__ __forceinline__ float mid_scale(int) const { return 1.f; }
    __device__ __forceinline__ float apply2(float rs, int row, int col, f32x4 vg, f32x4 vu) const {
        f32x4 a;
#pragma unroll
        for (int e = 0; e < 4; ++e) { const float g = rs * vg[e], u = rs * vu[e]; a[e] = g * sigmoidf_(g) * u; }
        st_bf4(act + (size_t)row * DFF + col, a); return 0.f;
    }
};
struct EpiDown {
    static constexpr bool MID = false, STATS = true, HAS_RS = false, QKN = false;
    float* st; bf16* hb;
    __device__ __forceinline__ float row_begin(int) const { return 1.f; }
    __device__ __forceinline__ float mid_scale(int) const { return 1.f; }
    __device__ __forceinline__ float apply(float, int row, int col, f32x4 v) const {
        bf16* p = hb + (size_t)row * D + col; const f32x4 h = ld_bf4(p) + v; st_bf4(p, h); return sumsq4(h);
    }
};
struct EpiPP {
    static constexpr bool MID = false, STATS = false, HAS_RS = false, QKN = false;
    float* st; bf16* pp;
    __device__ __forceinline__ float row_begin(int) const { return 1.f; }
    __device__ __forceinline__ float mid_scale(int) const { return 1.f; }
    __device__ __forceinline__ float apply(float, int row, int col, f32x4 v) const { st_bf4(pp + (size_t)row * D + col, v); return 0.f; }
};
struct EpiPle {
    static constexpr bool MID = false, STATS = true, HAS_RS = true, QKN = false;
    float* st; const float* sth2; int nsP, nsS; const bf16* pp; const bf16* hb; bf16* xb; float *yP, *yS; int last;
    __device__ __forceinline__ float row_begin(int row) const { return row_rs(sth2, row, row < MP ? nsP : nsS, 1.0f / D); }
    __device__ __forceinline__ float mid_scale(int) const { return 1.f; }
    __device__ __forceinline__ float apply(float rs, int row, int col, f32x4 v) const {
        const f32x4 h = ld_bf4(hb + (size_t)row * D + col); const f32x4 q = ld_bf4(pp + (size_t)row * D + col); f32x4 o;
#pragma unroll
        for (int e = 0; e < 4; ++e) o[e] = h[e] + sigmoidf_(rs * v[e]) * q[e];
        if (last) { float* y = row < MP ? yP + (size_t)row * D : yS + (size_t)(row - MP) * D; *(f32x4*)(y + col) = o; return 0.f; }
        st_bf4(xb + (size_t)row * D + col, o); return sumsq4(o);
    }
};

struct GArgs { const bf16* A; int lda; const bf16* Bt; int ldb; int K; int r0; int nrt; int nct; int kmid; };
template <int NB, bool PAIR, class F>
__device__ __forceinline__ void dg_gemm(const GArgs& g, const F& f, int gw, int ngw, int lane) {
    asm volatile("" : "+v"(lane));
    const int r32 = lane & 31, h = lane >> 5, ntiles = g.nrt * g.nct, nks = g.K / 16;
    for (int t = gw; t < ntiles; t += ngw) {
        const int tr = t / g.nct, tc = t % g.nct, row = g.r0 + 32 * tr + r32;
        int nb0, nb1, colbase;
        if (PAIR) { nb0 = 256 * (tc >> 2) + 32 * (tc & 3); nb1 = nb0 + 128; colbase = 32 * tc; } else { nb0 = 32 * NB * tc; nb1 = nb0 + 32; colbase = nb0; }
        const bf16* ap = g.A + (size_t)row * g.lda + 8 * h;
        const bf16* bp0 = g.Bt + (size_t)(nb0 + r32) * g.ldb + 8 * h;
        const bf16* bp1 = g.Bt + (size_t)(nb1 + r32) * g.ldb + 8 * h;
        f32x16 acc0 = {}, acc1 = {};
        const int k1 = F::MID ? g.kmid / 16 : nks;
#pragma unroll 4
        for (int ks = 0; ks < k1; ++ks) {
            const bf16x8 a = *(const bf16x8*)(ap + 16 * ks); const bf16x8 b0 = *(const bf16x8*)(bp0 + 16 * ks);
            acc0 = __builtin_amdgcn_mfma_f32_32x32x16_bf16(b0, a, acc0, 0, 0, 0);
            if (NB == 2) { const bf16x8 b1 = *(const bf16x8*)(bp1 + 16 * ks); acc1 = __builtin_amdgcn_mfma_f32_32x32x16_bf16(b1, a, acc1, 0, 0, 0); }
        }
        if (F::MID) {
            const float sc = f.mid_scale(row);
#pragma unroll
            for (int i = 0; i < 16; ++i) { acc0[i] *= sc; acc1[i] *= sc; }
#pragma unroll 4
            for (int ks = k1; ks < nks; ++ks) {
                const bf16x8 a = *(const bf16x8*)(ap + 16 * ks); const bf16x8 b0 = *(const bf16x8*)(bp0 + 16 * ks);
                acc0 = __builtin_amdgcn_mfma_f32_32x32x16_bf16(b0, a, acc0, 0, 0, 0);
                if (NB == 2) { const bf16x8 b1 = *(const bf16x8*)(bp1 + 16 * ks); acc1 = __builtin_amdgcn_mfma_f32_32x32x16_bf16(b1, a, acc1, 0, 0, 0); }
            }
        }
        const float rs = f.row_begin(row); float ss = 0.f;
        if constexpr (PAIR) {
#pragma unroll
            for (int gq = 0; gq < 4; ++gq) ss += f.apply2(rs, row, colbase + 8 * gq + 4 * h, (f32x4){acc0[4 * gq], acc0[4 * gq + 1], acc0[4 * gq + 2], acc0[4 * gq + 3]}, (f32x4){acc1[4 * gq], acc1[4 * gq + 1], acc1[4 * gq + 2], acc1[4 * gq + 3]});
        } else {
#pragma unroll
            for (int gq = 0; gq < 4; ++gq) ss += f.apply(rs, row, colbase + 8 * gq + 4 * h, (f32x4){acc0[4 * gq], acc0[4 * gq + 1], acc0[4 * gq + 2], acc0[4 * gq + 3]});
            if (NB == 2) {
#pragma unroll
                for (int gq = 0; gq < 4; ++gq) ss += f.apply(rs, row, colbase + 32 + 8 * gq + 4 * h, (f32x4){acc1[4 * gq], acc1[4 * gq + 1], acc1[4 * gq + 2], acc1[4 * gq + 3]});
            }
        }
        if (F::STATS) { ss += __shfl_xor(ss, 32); if (h == 0) f.st[(size_t)row * SS + tc] = ss; }
    }
}

__device__ __forceinline__ float log_sigmoid_fast(float z) { return fminf(z, 0.f) - 0.6931471805599453f * __builtin_amdgcn_logf(1.0f + __builtin_amdgcn_exp2f(fabsf(z) * -1.4426950408889634f)); }
__device__ __forceinline__ void flogit_rows(const Ctx& c, int l, int gw, int ngw, int lane, int nsS) {
    asm volatile("" : "+v"(lane));
    const bf16* xb = (const bf16*)(c.ws + WS_XB); const Lw w = layer_w(c, l);
    for (int row = MP + gw; row < MT; row += ngw) {
        const bf16* xp = xb + (size_t)row * D + 8 * lane; const bf16* wp = w.wf + 8 * lane;
        float a0 = 0.f, a1 = 0.f, a2 = 0.f, a3 = 0.f, a4 = 0.f, a5 = 0.f, a6 = 0.f, a7 = 0.f;
#pragma unroll
        for (int j = 0; j < 4; ++j) {
            const u32x4 xv = *(const u32x4*)(xp + 512 * j);
            const float x0 = bflo(xv.x), x1 = bfhi(xv.x), x2 = bflo(xv.y), x3 = bfhi(xv.y), x4 = bflo(xv.z), x5 = bfhi(xv.z), x6 = bflo(xv.w), x7 = bfhi(xv.w);
#define FL_DOT(a, h) { const u32x4 wv = *(const u32x4*)(wp + (size_t)(h) * D + 512 * j); \
            a += (x0 * bflo(wv.x) + x1 * bfhi(wv.x)) + (x2 * bflo(wv.y) + x3 * bfhi(wv.y)) + (x4 * bflo(wv.z) + x5 * bfhi(wv.z)) + (x6 * bflo(wv.w) + x7 * bfhi(wv.w)); }
            FL_DOT(a0, 0) FL_DOT(a1, 1) FL_DOT(a2, 2) FL_DOT(a3, 3) FL_DOT(a4, 4) FL_DOT(a5, 5) FL_DOT(a6, 6) FL_DOT(a7, 7)
#undef FL_DOT
        }
#define FL_RED(a) { a += __shfl_xor(a, 32); a += __shfl_xor(a, 16); a += __shfl_xor(a, 8); a += __shfl_xor(a, 4); a += __shfl_xor(a, 2); a += __shfl_xor(a, 1); }
        FL_RED(a0) FL_RED(a1) FL_RED(a2) FL_RED(a3) FL_RED(a4) FL_RED(a5) FL_RED(a6) FL_RED(a7)
#undef FL_RED
        float v = a0; v = lane == 1 ? a1 : v; v = lane == 2 ? a2 : v; v = lane == 3 ? a3 : v; v = lane == 4 ? a4 : v; v = lane == 5 ? a5 : v; v = lane == 6 ? a6 : v; v = lane == 7 ? a7 : v;
        const float rs = row_rs(stat_ptr(c, ST_X), row, nsS, 1.0f / D);
        if (lane < NH) c.out[O_LFS + ((size_t)l * MS + (row - MP)) * NH + lane] = log_sigmoid_fast(rs * v + c.in[11][l * NH + lane]);
    }
}

__device__ __forceinline__ void qknorm_rows(const Ctx& c, int l, int gw, int ngw, int lane) {
    asm volatile("" : "+v"(lane));
    bf16* qb = (bf16*)(c.ws + WS_QB); bf16* kb = (bf16*)(c.ws + WS_KB);
    float* kP = c.out + O_KP + (size_t)l * MP * AW; float* kS = c.out + O_KS + (size_t)l * MS * AW;
    const float* gq = c.in[12] + l * HD; const float* gk = c.in[13] + l * HD; const int d0 = (16 * lane) & 127;
    for (int row = MP + gw; row < MT; row += ngw) {
        bf16* qp = qb + (size_t)row * AW + 16 * lane; float q[16];
        { const u32x4 w0 = *(const u32x4*)qp, w1 = *(const u32x4*)(qp + 8);
          q[0] = bflo(w0.x); q[1] = bfhi(w0.x); q[2] = bflo(w0.y); q[3] = bfhi(w0.y); q[4] = bflo(w0.z); q[5] = bfhi(w0.z); q[6] = bflo(w0.w); q[7] = bfhi(w0.w);
          q[8] = bflo(w1.x); q[9] = bfhi(w1.x); q[10] = bflo(w1.y); q[11] = bfhi(w1.y); q[12] = bflo(w1.z); q[13] = bfhi(w1.z); q[14] = bflo(w1.w); q[15] = bfhi(w1.w); }
        float ss = 0.f;
#pragma unroll
        for (int e = 0; e < 16; ++e) ss += q[e] * q[e];
        ss += __shfl_xor(ss, 1); ss += __shfl_xor(ss, 2); ss += __shfl_xor(ss, 4);
        float sc = rsqrtf(ss * (1.0f / HD) + EPS) * QSCALE;
#pragma unroll
        for (int e = 0; e < 16; ++e) q[e] *= sc * gq[d0 + e];
        { u32x4 o0, o1; o0.x = cvtpk(q[0], q[1]); o0.y = cvtpk(q[2], q[3]); o0.z = cvtpk(q[4], q[5]); o0.w = cvtpk(q[6], q[7]); o1.x = cvtpk(q[8], q[9]); o1.y = cvtpk(q[10], q[11]); o1.z = cvtpk(q[12], q[13]); o1.w = cvtpk(q[14], q[15]);
          *(u32x4*)qp = o0; *(u32x4*)(qp + 8) = o1; }
        float* kp = (row < MP ? kP + (size_t)row * AW : kS + (size_t)(row - MP) * AW) + 16 * lane; float k[16];
#pragma unroll
        for (int j = 0; j < 4; ++j) { const f32x4 v = *(const f32x4*)(kp + 4 * j); k[4 * j] = v.x; k[4 * j + 1] = v.y; k[4 * j + 2] = v.z; k[4 * j + 3] = v.w; }
        ss = 0.f;
#pragma unroll
        for (int e = 0; e < 16; ++e) ss += k[e] * k[e];
        ss += __shfl_xor(ss, 1); ss += __shfl_xor(ss, 2); ss += __shfl_xor(ss, 4);
        sc = rsqrtf(ss * (1.0f / HD) + EPS);
#pragma unroll
        for (int e = 0; e < 16; ++e) k[e] *= sc * gk[d0 + e];
#pragma unroll
        for (int j = 0; j < 4; ++j) *(f32x4*)(kp + 4 * j) = (f32x4){k[4 * j], k[4 * j + 1], k[4 * j + 2], k[4 * j + 3]};
        { bf16* kbp = kb + (size_t)row * AW + 16 * lane; u32x4 o0, o1; o0.x = cvtpk(k[0], k[1]); o0.y = cvtpk(k[2], k[3]); o0.z = cvtpk(k[4], k[5]); o0.w = cvtpk(k[6], k[7]); o1.x = cvtpk(k[8], k[9]); o1.y = cvtpk(k[10], k[11]); o1.z = cvtpk(k[12], k[13]); o1.w = cvtpk(k[14], k[15]);
          *(u32x4*)kbp = o0; *(u32x4*)(kbp + 8) = o1; }
    }
}

__device__ __forceinline__ void cumsum_simple(const Ctx& c, int l, int gw, int ngw, int lane) {
    asm volatile("" : "+v"(lane));
    float* cumP = (float*)(c.ws + WS_CUM); float* cumS = cumP + (size_t)MP * NH;
    const float* lfP = c.out + O_LFP + (size_t)l * MP * NH; const float* lfS = c.out + O_LFS + (size_t)l * MS * NH; const float* cl = c.in[4] + (size_t)l * DBAT * PAST * NH;
    for (int it = gw; it < NBAT * NH + DBAT * NH; it += ngw) {
        const bool smp = it >= NBAT * NH; const int i2 = smp ? it - NBAT * NH : it, b = i2 >> 3, h = i2 & 7, n = smp ? PAST + DSEQ : SEQ, per = (n + 63) / 64;
        float loc = 0.f;
        for (int j = 0; j < per; ++j) { const int t = lane * per + j; if (t < n) loc += smp ? (t < PAST ? cl[((size_t)b * PAST + t) * NH + h] : lfS[((size_t)b * DSEQ + (t - PAST)) * NH + h]) : lfP[((size_t)b * SEQ + t) * NH + h]; }
        float inc = loc;
#pragma unroll
        for (int o = 1; o < 64; o <<= 1) { const float v = __shfl_up(inc, o); if (lane >= o) inc += v; }
        float run = inc - loc;
        for (int j = 0; j < per; ++j) { const int t = lane * per + j; if (t < n) {
            run += smp ? (t < PAST ? cl[((size_t)b * PAST + t) * NH + h] : lfS[((size_t)b * DSEQ + (t - PAST)) * NH + h]) : lfP[((size_t)b * SEQ + t) * NH + h];
            if (smp) cumS[((size_t)b * (PAST + DSEQ) + t) * NH + h] = run * LOG2E; else cumP[((size_t)b * SEQ + t) * NH + h] = run * LOG2E; } }
    }
}
__device__ __forceinline__ void attn_simple(const Ctx& c, int l, int gw, int ngw, int lane, int row_lo = 0, int row_hi = MT) {
    asm volatile("" : "+v"(lane));
    const bf16* qb = (const bf16*)(c.ws + WS_QB); const bf16* kb = (const bf16*)(c.ws + WS_KB); const bf16* vb = (const bf16*)(c.ws + WS_VB); bf16* mg = (bf16*)(c.ws + WS_MG);
    const float* cumP = (const float*)(c.ws + WS_CUM); const float* cumS = cumP + (size_t)MP * NH; float* sta = stat_ptr(c, ST_A);
    const float* ck_ = c.in[2] + (size_t)l * DBAT * PAST * AW; const float* cv_ = c.in[3] + (size_t)l * DBAT * PAST * AW;
    for (int it = row_lo * NH + gw; it < row_hi * NH; it += ngw) {
        const int row = it >> 3, h = it & 7; const bool smp = row >= MP; const int r = row - MP;
        const int b = smp ? r >> 4 : row >> 11, pos = smp ? PAST + (r & 15) : row & 2047, nkeys = pos + 1;
        unsigned qv[64];
#pragma unroll
        for (int j = 0; j < 16; ++j) { const u32x4 w = *(const u32x4*)(qb + (size_t)row * AW + h * HD + 8 * j); qv[4 * j] = w.x; qv[4 * j + 1] = w.y; qv[4 * j + 2] = w.z; qv[4 * j + 3] = w.w; }
        const float cq = smp ? cumS[((size_t)b * (PAST + DSEQ) + pos) * NH + h] : cumP[(size_t)row * NH + h];
        float m = -1e30f, lsum = 0.f, o0 = 0.f, o1 = 0.f;
        for (int k0 = 0; k0 < nkeys; k0 += 64) {
            const int j = k0 + lane; const bool valid = j < nkeys; float s = 0.f;
            if (valid) {
                if (smp && j < PAST) { const float* kp = ck_ + ((size_t)b * PAST + j) * AW + h * HD;
#pragma unroll
                    for (int d = 0; d < 32; ++d) { const f32x4 kv = *(const f32x4*)(kp + 4 * d); s += bflo(qv[2 * d]) * kv.x + bfhi(qv[2 * d]) * kv.y + bflo(qv[2 * d + 1]) * kv.z + bfhi(qv[2 * d + 1]) * kv.w; }
                } else { const int kr = smp ? MP + b * DSEQ + (j - PAST) : (b << 11) + j; const bf16* kp = kb + (size_t)kr * AW + h * HD;
#pragma unroll
                    for (int d = 0; d < 16; ++d) { const u32x4 w = *(const u32x4*)(kp + 8 * d);
                        s += bflo(qv[4 * d]) * bflo(w.x) + bfhi(qv[4 * d]) * bfhi(w.x) + bflo(qv[4 * d + 1]) * bflo(w.y) + bfhi(qv[4 * d + 1]) * bfhi(w.y)
                           + bflo(qv[4 * d + 2]) * bflo(w.z) + bfhi(qv[4 * d + 2]) * bfhi(w.z) + bflo(qv[4 * d + 3]) * bflo(w.w) + bfhi(qv[4 * d + 3]) * bfhi(w.w); } }
                const float ck = smp ? cumS[((size_t)b * (PAST + DSEQ) + j) * NH + h] : cumP[((size_t)(b << 11) + j) * NH + h];
                s += cq - ck;
            } else s = -__builtin_inff();
            const float mn = fmaxf(m, wave_max(s)), alpha = __builtin_amdgcn_exp2f(m - mn), p = __builtin_amdgcn_exp2f(s - mn);
            lsum = lsum * alpha + wave_sum(p); o0 *= alpha; o1 *= alpha; m = mn;
            const int cnt = (nkeys - k0) < 64 ? (nkeys - k0) : 64;
            for (int jj = 0; jj < cnt; ++jj) { const float pj = __shfl(p, jj); const int jk = k0 + jj; float v0, v1;
                if (smp && jk < PAST) { const f32x2 vv = *(const f32x2*)(cv_ + ((size_t)b * PAST + jk) * AW + h * HD + 2 * lane); v0 = vv.x; v1 = vv.y; }
                else { const int kr = smp ? MP + b * DSEQ + (jk - PAST) : (b << 11) + jk; const unsigned w = *(const unsigned*)(vb + (size_t)kr * AW + h * HD + 2 * lane); v0 = bflo(w); v1 = bfhi(w); }
                o0 += pj * v0; o1 += pj * v1; }
        }
        const float inv = 1.0f / lsum; o0 *= inv; o1 *= inv;
        *(unsigned*)(mg + (size_t)row * D + h * HD + 2 * lane) = cvtpk(o0, o1);
        const float ss = wave_sum(o0 * o0 + o1 * o1); if (lane == 0) sta[(size_t)row * SS + h] = ss;
    }
}
__device__ __forceinline__ void ssm_simple(const Ctx& c, int l, int gw, int ngw, int lane) {
    asm volatile("" : "+v"(lane));
    const Lw w = layer_w(c, l); const bf16* ub = (const bf16*)(c.ws + WS_UB); bf16* gs = (bf16*)(c.ws + WS_GS);
    for (int it = gw; it < NBAT * NG + DBAT * NG; it += ngw) {
        const bool smp = it >= NBAT * NG; const int i2 = smp ? it - NBAT * NG : it, b = i2 / NG, g = i2 % NG, T = smp ? DSEQ : SEQ;
        const bf16* u = ub + (smp ? UB_S_OFF + (size_t)(b * NG + g) * DSEQ * 16 : (size_t)(b * NG + g) * SEQ * 16);
        const float abr = w.abr[g * NP + lane], abi = w.abi[g * NP + lane];
        float Br[16], Bi[16], Cr[16], Ci[16];
#pragma unroll
        for (int ch = 0; ch < 16; ++ch) { Br[ch] = bf2f(w.bcat[((size_t)g * 128 + lane) * 16 + ch]); Bi[ch] = bf2f(w.bcat[((size_t)g * 128 + 64 + lane) * 16 + ch]);
            Cr[ch] = bf2f(w.ccat[((size_t)g * 16 + ch) * 128 + lane]); Ci[ch] = bf2f(w.ccat[((size_t)g * 16 + ch) * 128 + 64 + lane]); }
        const float dsk = c.in[21][l * SW + g * 16 + (lane & 15)];
        float xr = 0.f, xi = 0.f;
        if (smp) { xr = c.in[5][(((size_t)l * DBAT + b) * NG + g) * NP + lane]; xi = c.in[6][(((size_t)l * DBAT + b) * NG + g) * NP + lane]; }
        for (int t = 0; t < T; ++t) {
            const u32x4 w0 = *(const u32x4*)(u + t * 16), w1 = *(const u32x4*)(u + t * 16 + 8);
            const float uu[16] = {bflo(w0.x), bfhi(w0.x), bflo(w0.y), bfhi(w0.y), bflo(w0.z), bfhi(w0.z), bflo(w0.w), bfhi(w0.w), bflo(w1.x), bfhi(w1.x), bflo(w1.y), bfhi(w1.y), bflo(w1.z), bfhi(w1.z), bflo(w1.w), bfhi(w1.w)};
            float bur = 0.f, bui = 0.f;
#pragma unroll
            for (int ch = 0; ch < 16; ++ch) { bur += Br[ch] * uu[ch]; bui += Bi[ch] * uu[ch]; }
            const float nxr = abr * xr - abi * xi + bur, nxi = abr * xi + abi * xr + bui; xr = nxr; xi = nxi;
            float yl = 0.f;
#pragma unroll
            for (int ch = 0; ch < 16; ++ch) { const float y = wave_sum(Cr[ch] * xr + Ci[ch] * xi); if (lane == ch) yl = y; }
            if (lane < 16) { const float y = yl + dsk * bf2f(u[t * 16 + lane]); const int row = smp ? MP + b * DSEQ + t : b * SEQ + t;
                gs[(size_t)row * SW + g * 16 + lane] = (bf16)(cvtpk(gelu_tanh_(y), 0.f) & 0xffff); }
        }
        float* sre = smp ? c.out + O_SRS + (((size_t)l * DBAT + b) * NG + g) * NP : c.out + O_SRP + (((size_t)l * NBAT + b) * NG + g) * NP;
        float* sim = smp ? c.out + O_SIS + (((size_t)l * DBAT + b) * NG + g) * NP : c.out + O_SIP + (((size_t)l * NBAT + b) * NG + g) * NP;
        sre[lane] = xr; sim[lane] = xi;
    }
}

#define XB_TMO      128
#define XB_XCNT(j)  (256  + 64 * (j))
#define XB_XSUB(j)  (1280 + 64 * (j))
#define XB_XGEN(j)  (2304 + 64 * (j))
#define XB_TOP      3328
#define XB_TOPGEN   3392
#define XCD_BAR_WORDS 3456
#define XB_SPIN_CAP (1u << 24)

__device__ __forceinline__ unsigned xb_ld(unsigned* p)              { return __hip_atomic_load(p, __ATOMIC_RELAXED, __HIP_MEMORY_SCOPE_AGENT); }
__device__ __forceinline__ unsigned xb_add(unsigned* p, unsigned v) { return __hip_atomic_fetch_add(p, v, __ATOMIC_RELAXED, __HIP_MEMORY_SCOPE_AGENT); }
__device__ __forceinline__ unsigned xb_xcc_id() { return (unsigned)__builtin_amdgcn_s_getreg((3 << 11) | 20) & 0xFu; }
#define XB_SPIN(cond, bar) do { unsigned _sp = 0; while (cond) { __builtin_amdgcn_s_sleep(1); \
    if ((++_sp & 255u) == 0u) { if (xb_ld(&(bar)[XB_TMO])) break; if (_sp > XB_SPIN_CAP) { atomicAdd(&(bar)[XB_TMO], 1u); break; } } } } while (0)

struct XcdBarrier {
    unsigned* bar; unsigned x;
    volatile LAS unsigned* st;
};

__device__ __forceinline__ XcdBarrier xcd_barrier_post(unsigned* bar, volatile LAS unsigned* st) {
    XcdBarrier b; b.bar = bar; b.x = xb_xcc_id(); b.st = st;
    if (threadIdx.x == 0) (void)xb_add(&bar[XB_XCNT(b.x)], 1u);
    return b;
}
__device__ __forceinline__ void xcd_barrier_complete(unsigned* bar, unsigned x, unsigned& nloc, unsigned& nx) {
    const unsigned G = gridDim.x * gridDim.y * gridDim.z;
    unsigned sum, cnt, mine, sp = 0u;
    for (;;) {
        sum = 0u; cnt = 0u; mine = 0u;
#pragma unroll
        for (unsigned j = 0; j < 16; ++j) { const unsigned c = xb_ld(&bar[XB_XCNT(j)]); sum += c; cnt += (c > 0u) ? 1u : 0u; mine = (j == x) ? c : mine; }
        if (sum == G) break;
        __builtin_amdgcn_s_sleep(1);
        if ((++sp & 255u) == 0u) { if (xb_ld(&bar[XB_TMO])) break; if (sp > XB_SPIN_CAP) { atomicAdd(&bar[XB_TMO], 1u); break; } }
    }
    nloc = mine > 0u ? mine : 1u; nx = cnt > 0u ? cnt : 1u;
}

__device__ __forceinline__ void xcd_barrier(const XcdBarrier& b) {
    asm volatile("s_waitcnt vmcnt(0)" ::: "memory");
    __syncthreads();
    if (threadIdx.x == 0) {
        unsigned* bar = b.bar;
        __builtin_amdgcn_s_waitcnt(0);
        unsigned nloc = b.st[0], nx = b.st[1];
        if (nloc == 0u) { xcd_barrier_complete(bar, b.x, nloc, nx); b.st[0] = nloc; b.st[1] = nx; }
        const unsigned old = xb_add(&bar[XB_XSUB(b.x)], 1u);
        const unsigned gen = old / nloc;
        if (old + 1u == (gen + 1u) * nloc) {
            __builtin_amdgcn_fence(__ATOMIC_RELEASE, "agent");
            asm volatile("s_waitcnt vmcnt(0)" ::: "memory");
            const unsigned og = xb_add(&bar[XB_TOP], 1u);
            const unsigned tg = og / nx;
            if (og + 1u == (tg + 1u) * nx) xb_add(&bar[XB_TOPGEN], 1u);
            else XB_SPIN(xb_ld(&bar[XB_TOPGEN]) == tg, bar);
            __builtin_amdgcn_fence(__ATOMIC_ACQUIRE, "agent");
            xb_add(&bar[XB_XGEN(b.x)], 1u);
            asm volatile("s_waitcnt vmcnt(0)" ::: "memory");
        } else {
            XB_SPIN(xb_ld(&bar[XB_XGEN(b.x)]) == gen, bar);
            __builtin_amdgcn_fence(__ATOMIC_ACQUIRE, "agent");
            asm volatile("s_waitcnt vmcnt(0)" ::: "memory");
        }
    }
    __syncthreads();
}


namespace pg8 {
constexpr int BM = 256, BK = 64, HALF = 128, HTB = HALF * BK * 2, STAGE_BYTES = 8 * HTB, NXCD = 8, WGM = 8;
__host__ __device__ __forceinline__ int lds_byte(int r, int c) { const int st = (r >> 4) * 2 + (c >> 5), rr = r & 15, cc = c & 31, ob = rr * 64 + cc * 2; return st * 1024 + (ob ^ (((ob >> 9) & 1) << 5)); }
__host__ __device__ __forceinline__ void stage_rc(int b, int& R, int& C) { const int st = b / 1024, sb = b % 1024, swz = sb ^ (((sb >> 9) & 1) << 5); R = (st >> 1) * 16 + swz / 64; C = (st & 1) * 32 + (swz % 64) / 2; }
struct Unit { int pm, pn; };
struct Gemm { const bf16* A; const bf16* Bt; int M, N, K; };
struct StaticOrder {
    int nM, nN, nwg, G, c;
    __host__ __device__ __forceinline__ void init(int M, int N, int G_, int c_) { nM = M / BM; nN = N / BM; nwg = nM * nN; G = G_; c = c_; }
    __host__ __device__ __forceinline__ bool next(int i, Unit& u) const {
        const long L = (long)i * G + c; if (L >= nwg) return false;
        int wgid = (int)L; { const int q = nwg / NXCD, r = nwg % NXCD, xcd = wgid % NXCD, off = wgid / NXCD; wgid = (xcd < r ? xcd * (q + 1) : r * (q + 1) + (xcd - r) * q) + off; }
        const int nig = WGM * nN, gid = wgid / nig, fm = gid * WGM, gsz = (nM - fm) < WGM ? (nM - fm) : WGM;
        u.pm = fm + ((wgid % nig) % gsz); u.pn = (wgid % nig) / gsz; return true;
    }
};
template <bool PAIR, class F>
__device__ __forceinline__ void epi256(const f32x4 (&acc)[2][2][4][2], const Unit& u, int wr, int wc, int fr, int fq, const F& f, LAS float* red, int tid) {
    LAS float* rtab = red + 1600;
    if (F::HAS_RS) { if (tid < 256) rtab[tid] = f.row_begin(u.pm * BM + tid);
        asm volatile("s_waitcnt lgkmcnt(0)" ::: "memory"); __builtin_amdgcn_s_barrier(); asm volatile("" ::: "memory"); }
    if constexpr (F::QKN) {
        if (u.pn < 8) {
            LAS float* r2 = red - 4096;
#pragma unroll
            for (int ai = 0; ai < 2; ++ai)
#pragma unroll
                for (int m = 0; m < 4; ++m) { const int rl = ai * HALF + wr * 64 + m * 16 + fr; const float rs = rtab[rl];
#pragma unroll
                    for (int bj = 0; bj < 2; ++bj) { const f32x4 a = acc[ai][bj][m][0] * rs, b = acc[ai][bj][m][1] * rs; float ss = sumsq4(a) + sumsq4(b);
                        ss += __shfl_xor(ss, 16); ss += __shfl_xor(ss, 32); if (fq == 0) r2[(rl * 2 + bj) * 4 + wc] = ss; } }
            asm volatile("s_waitcnt lgkmcnt(0)" ::: "memory"); __builtin_amdgcn_s_barrier(); asm volatile("" ::: "memory");
            const bool isq = u.pn < 4; const float* gv = isq ? f.gq : f.gk;
#pragma unroll
            for (int ai = 0; ai < 2; ++ai)
#pragma unroll
                for (int m = 0; m < 4; ++m) { const int rl = ai * HALF + wr * 64 + m * 16 + fr, row = u.pm * BM + rl; const float rs = rtab[rl];
#pragma unroll
                    for (int bj = 0; bj < 2; ++bj) { const f32x4 p4 = *(const LAS f32x4*)(r2 + (rl * 2 + bj) * 4);
                        const float sc = rs * rsqrtf(((p4.x + p4.y) + (p4.z + p4.w)) * (1.0f / HD) + EPS) * (isq ? QSCALE : 1.0f);
#pragma unroll
                        for (int n = 0; n < 2; ++n) { const int d = wc * 32 + n * 16 + 4 * fq, col = (u.pn & 3) * BM + bj * HALF + d; const f32x4 o = acc[ai][bj][m][n] * sc * *(const f32x4*)(gv + d);
                            if (isq) st_bf4(f.qb + (size_t)row * AW + col, o);
                            else { *(f32x4*)(f.kP + (size_t)row * AW + col) = o; st_bf4(f.kb + (size_t)row * AW + col, o); } } }
                    if (m & 1) asm volatile("" ::: "memory"); }
            return;
        }
    }
#pragma unroll
    for (int ai = 0; ai < 2; ++ai)
#pragma unroll
        for (int m = 0; m < 4; ++m) {
            const int rl = ai * HALF + wr * 64 + m * 16 + fr, row = u.pm * BM + rl; const float rs = F::HAS_RS ? rtab[rl] : 1.f; float ss = 0.f;
            if constexpr (PAIR) {
#pragma unroll
                for (int n = 0; n < 2; ++n) ss += f.apply2(rs, row, u.pn * HALF + wc * 32 + n * 16 + 4 * fq, acc[ai][0][m][n], acc[ai][1][m][n]);
            } else {
#pragma unroll
                for (int bj = 0; bj < 2; ++bj)
#pragma unroll
                    for (int n = 0; n < 2; ++n) ss += f.apply(rs, row, u.pn * BM + bj * HALF + wc * 32 + n * 16 + 4 * fq, acc[ai][bj][m][n]);
            }
            if (F::STATS) { ss += __shfl_xor(ss, 16); ss += __shfl_xor(ss, 32); if (fq == 0) red[rl * 4 + wc] = ss; }
            if (m == 3) asm volatile("" ::: "memory");
        }
    if (F::STATS) {
        asm volatile("s_waitcnt lgkmcnt(0)" ::: "memory"); __builtin_amdgcn_s_barrier(); asm volatile("" ::: "memory");
        if (tid < 256) { const f32x4 p = *(const LAS f32x4*)(red + tid * 4); f.st[(size_t)(u.pm * BM + tid) * SS + u.pn] = (p.x + p.y) + (p.z + p.w); }
    }
}
template <bool PAIR, class F>
__device__ __forceinline__ void gemm_phase(LAS unsigned char* lds, LAS float* red, const Gemm g, const StaticOrder& S, const F& E, int tid) {
    asm volatile("" : "+v"(tid));
    const int wid = __builtin_amdgcn_readfirstlane(tid >> 6), lane = tid & 63, wr = wid >> 2, wc = wid & 3, fr = lane & 15, fq = lane >> 4;
    const int K = g.K, nt = K / BK;
    unsigned voffA[2];
#pragma unroll
    for (int i = 0; i < 2; ++i) { int R, C; stage_rc(tid * 16 + i * 8192, R, C); voffA[i] = (unsigned)(R * K + C) * 2u; }
    const size_t kstep = (size_t)(BK * 2), hstep = (size_t)HALF * K * 2, tstep = 2 * hstep;
    const unsigned ldsw = (unsigned)wid * 1024u;
    const int aoff = lds_byte(wr * 64 + fr, fq * 8), boff = lds_byte(wc * 32 + fr, fq * 8);
#define PG8_SA(b, h) (((b) * 2 + (h)) * HTB)
#define PG8_SB(b, h) ((4 + (b) * 2 + (h)) * HTB)
#define PG8_STAGE(bufoff, gbase) do { _Pragma("unroll") for (int _i = 0; _i < 2; ++_i) \
        __builtin_amdgcn_global_load_lds((const unsigned*)((const char*)(gbase) + voffA[_i]), (LAS unsigned*)(lds + (bufoff) + ldsw + _i * 8192), 16, 0, 0); } while (0)
#define PG8_LDA(dst, b, h) do { _Pragma("unroll") for (int m = 0; m < 4; ++m) _Pragma("unroll") for (int k = 0; k < 2; ++k) dst[m][k] = *(const LAS bf16x8*)(lds + PG8_SA(b, h) + aoff + m * 2048 + k * 1024); } while (0)
#define PG8_LDB(dst, b, h) do { _Pragma("unroll") for (int n = 0; n < 2; ++n) _Pragma("unroll") for (int k = 0; k < 2; ++k) dst[n][k] = *(const LAS bf16x8*)(lds + PG8_SB(b, h) + boff + n * 2048 + k * 1024); } while (0)
#define PG8_MMA(ai, bj, At, Bt) do { __builtin_amdgcn_s_setprio(1); _Pragma("unroll") for (int m = 0; m < 4; ++m) _Pragma("unroll") for (int n = 0; n < 2; ++n) _Pragma("unroll") for (int k = 0; k < 2; ++k) \
        acc[ai][bj][m][n] = __builtin_amdgcn_mfma_f32_16x16x32_bf16(Bt[n][k], At[m][k], acc[ai][bj][m][n], 0, 0, 0); __builtin_amdgcn_s_setprio(0); } while (0)
#define PG8_WAIT_V(n) asm volatile("s_waitcnt vmcnt(" #n ")" ::: "memory")
#define PG8_WAIT_L(n) asm volatile("s_waitcnt lgkmcnt(" #n ")" ::: "memory")
#define PG8_BAR __builtin_amdgcn_s_barrier()
#define PG8_SCHED __builtin_amdgcn_sched_barrier(0)
    Unit cur, nxt; int ui = 0;
    if (!S.next(0, cur)) return;
    f32x4 acc[2][2][4][2];
#pragma unroll
    for (int a = 0; a < 2; ++a)
#pragma unroll
        for (int b = 0; b < 2; ++b)
#pragma unroll
            for (int m = 0; m < 4; ++m)
#pragma unroll
                for (int n = 0; n < 2; ++n) acc[a][b][m][n] = (f32x4){0.f, 0.f, 0.f, 0.f};
    bf16x8 At[4][2], B0[2][2], B1[2][2];
    const char* cA = (const char*)g.A + (size_t)cur.pm * tstep; const char* cB = (const char*)g.Bt + (size_t)cur.pn * tstep;
    PG8_STAGE(PG8_SB(0, 0), cB); PG8_STAGE(PG8_SB(0, 1), cB + hstep); PG8_STAGE(PG8_SA(0, 0), cA); PG8_STAGE(PG8_SA(0, 1), cA + hstep);
    if (wr == 1) PG8_BAR;
    PG8_WAIT_V(2); PG8_BAR;
    PG8_STAGE(PG8_SB(1, 0), cB + kstep); PG8_STAGE(PG8_SA(1, 0), cA + kstep); PG8_STAGE(PG8_SB(1, 1), cB + hstep + kstep);
    PG8_WAIT_V(6); PG8_BAR;
    for (;;) {
        const bool has_next = S.next(ui + 1, nxt);
        const char* nA = has_next ? (const char*)g.A + (size_t)nxt.pm * tstep : cA; const char* nB = has_next ? (const char*)g.Bt + (size_t)nxt.pn * tstep : cB;
        for (int t = 0; t < nt; t += 2) {
            const bool last = (t == nt - 2);
            const char* a1 = cA + (size_t)(t + 1) * kstep;
            const char* a2 = last ? nA : cA + (size_t)(t + 2) * kstep; const char* b2 = last ? nB : cB + (size_t)(t + 2) * kstep;
            const char* a3 = a2 + kstep; const char* b3 = b2 + kstep;
            if constexpr (F::MID) { if (t == nt / 2) {
#pragma unroll
                for (int ai = 0; ai < 2; ++ai)
#pragma unroll
                    for (int m = 0; m < 4; ++m) { const float sc = E.mid_tab[ui * BM + ai * HALF + wr * 64 + m * 16 + fr];
#pragma unroll
                        for (int bj = 0; bj < 2; ++bj)
#pragma unroll
                            for (int n = 0; n < 2; ++n) acc[ai][bj][m][n] = acc[ai][bj][m][n] * sc; }
            } }
            PG8_LDB(B0, 0, 0); PG8_LDB(B1, 0, 1); PG8_SCHED; PG8_LDA(At, 0, 0); PG8_STAGE(PG8_SA(1, 1), a1 + hstep);
            PG8_WAIT_V(8); PG8_WAIT_L(0); PG8_BAR; PG8_MMA(0, 0, At, B0); PG8_MMA(0, 1, At, B1); PG8_BAR; PG8_SCHED;
            PG8_LDA(At, 0, 1); PG8_STAGE(PG8_SB(0, 0), b2); PG8_STAGE(PG8_SB(0, 1), b2 + hstep); PG8_STAGE(PG8_SA(0, 0), a2);
            PG8_WAIT_V(8); PG8_WAIT_L(0); PG8_BAR; PG8_MMA(1, 0, At, B0); PG8_MMA(1, 1, At, B1); PG8_BAR; PG8_SCHED;
            PG8_LDB(B0, 1, 0); PG8_LDB(B1, 1, 1); PG8_SCHED; PG8_LDA(At, 1, 0); PG8_STAGE(PG8_SA(0, 1), a2 + hstep);
            PG8_WAIT_V(8); PG8_WAIT_L(0); PG8_BAR; PG8_MMA(0, 0, At, B0); PG8_MMA(0, 1, At, B1); PG8_BAR; PG8_SCHED;
            PG8_LDA(At, 1, 1); PG8_STAGE(PG8_SB(1, 0), b3); PG8_STAGE(PG8_SB(1, 1), b3 + hstep); PG8_STAGE(PG8_SA(1, 0), a3);
            PG8_WAIT_V(8); PG8_WAIT_L(0); PG8_BAR; PG8_MMA(1, 0, At, B0); PG8_MMA(1, 1, At, B1); PG8_BAR; PG8_SCHED;
        }
        if (wr == 0) PG8_BAR;
        epi256<PAIR>(acc, cur, wr, wc, fr, fq, E, red, tid);
        if (!has_next) break;
#pragma unroll
        for (int a = 0; a < 2; ++a)
#pragma unroll
            for (int b = 0; b < 2; ++b)
#pragma unroll
                for (int m = 0; m < 4; ++m)
#pragma unroll
                    for (int n = 0; n < 2; ++n) acc[a][b][m][n] = (f32x4){0.f, 0.f, 0.f, 0.f};
        cur = nxt; cA = nA; cB = nB; ++ui;
        if (wr == 1) PG8_BAR;
    }
    PG8_WAIT_V(0);
    PG8_BAR;
#undef PG8_SA
#undef PG8_SB
#undef PG8_STAGE
#undef PG8_LDA
#undef PG8_LDB
#undef PG8_MMA
#undef PG8_WAIT_V
#undef PG8_WAIT_L
#undef PG8_BAR
#undef PG8_SCHED
}
}

namespace att {
typedef short v4i16_t __attribute__((ext_vector_type(4)));
__device__ __forceinline__ int kswz(int row, int colB) { return row * 256 + (colB ^ ((row & 7) << 4)); }
__device__ __forceinline__ s16x4 vtr(const LAS unsigned char* p) { return __builtin_bit_cast(s16x4, __builtin_amdgcn_ds_read_tr16_b64_v4i16((LAS v4i16_t*)p)); }
__device__ __forceinline__ bf16x8 pack8(const f32x16& p, int b) {
    u32x4 w; w.x = cvtpk(p[b + 0], p[b + 1]); w.y = cvtpk(p[b + 2], p[b + 3]); w.z = cvtpk(p[b + 4], p[b + 5]); w.w = cvtpk(p[b + 6], p[b + 7]); return __builtin_bit_cast(bf16x8, w);
}
struct State { f32x16 o[4]; float m, l; };
template <int NBK, int VBS, bool MASK>
__device__ __forceinline__ void tile(State& S, const bf16x8 (&qr)[8], const LAS unsigned char* Kb, const LAS unsigned char* Vb, const LAS float* ckp, float cq, int dq, int lane) {
    const int r32 = lane & 31, h2 = lane >> 5;
    f32x16 p[NBK];
#pragma unroll
    for (int nb = 0; nb < NBK; ++nb) p[nb] = (f32x16){0.f, 0.f, 0.f, 0.f, 0.f, 0.f, 0.f, 0.f, 0.f, 0.f, 0.f, 0.f, 0.f, 0.f, 0.f, 0.f};
    const int kx = (r32 & 7) << 4;
    const LAS unsigned char* kp4[4];
#pragma unroll
    for (int j = 0; j < 4; ++j) kp4[j] = Kb + r32 * 256 + ((32 * j + 16 * h2) ^ kx);
#pragma unroll
    for (int kq = 0; kq < 4; ++kq) {
        bf16x8 kf[2][NBK];
#pragma unroll
        for (int j = 0; j < 2; ++j)
#pragma unroll
            for (int nb = 0; nb < NBK; ++nb) kf[j][nb] = *(const LAS bf16x8*)(kp4[(2 * kq + j) & 3] + ((2 * kq + j) >> 2) * 128 + nb * 8192);
#pragma unroll
        for (int j = 0; j < 2; ++j)
#pragma unroll
            for (int nb = 0; nb < NBK; ++nb) p[nb] = __builtin_amdgcn_mfma_f32_32x32x16_bf16(kf[j][nb], qr[2 * kq + j], p[nb], 0, 0, 0);
        __builtin_amdgcn_sched_barrier(0);
    }
    float mx = -__builtin_inff();
#pragma unroll
    for (int nb = 0; nb < NBK; ++nb)
#pragma unroll
        for (int g = 0; g < 4; ++g) { const f32x4 ck = *(const LAS f32x4*)(ckp + nb * 32 + 8 * g + 4 * h2);
#pragma unroll
            for (int e = 0; e < 4; ++e) { float s = p[nb][4 * g + e] + (cq - ck[e]);
                if (MASK) { const int kk = nb * 32 + 8 * g + 4 * h2 + e; if (kk > dq) s = -__builtin_inff(); }
                p[nb][4 * g + e] = s; mx = fmaxf(mx, s); } }
    __builtin_amdgcn_sched_barrier(0);
    mx = fmaxf(mx, __shfl_xor(mx, 32));
    const float mn = (mx > S.m + 8.0f) ? mx : S.m;
    const float alpha = __builtin_amdgcn_exp2f(S.m - mn); const bool resc = __any(mn != S.m); S.m = mn;
    float ls = 0.f;
#pragma unroll
    for (int nb = 0; nb < NBK; ++nb)
#pragma unroll
        for (int i = 0; i < 16; ++i) { const float e = __builtin_amdgcn_exp2f(p[nb][i] - mn); p[nb][i] = e; ls += e; }
    S.l = S.l * alpha + ls;
    if (resc) {
#pragma unroll
        for (int d = 0; d < 4; ++d)
#pragma unroll
            for (int i = 0; i < 16; ++i) S.o[d][i] *= alpha; }
    bf16x8 pa[2 * NBK];
#pragma unroll
    for (int nb = 0; nb < NBK; ++nb) { pa[2 * nb] = pack8(p[nb], 0); pa[2 * nb + 1] = pack8(p[nb], 8); }
    const LAS unsigned char* vp = Vb + (4 * h2 + ((lane >> 2) & 3)) * 64 + ((lane >> 4) & 1) * 32 + (lane & 3) * 8;
    __builtin_amdgcn_sched_barrier(0);
#pragma unroll
    for (int d = 0; d < 4; ++d) {
        s16x4 lo[2 * NBK], hi[2 * NBK];
#pragma unroll
        for (int s = 0; s < 2 * NBK; ++s) { lo[s] = vtr(vp + d * VBS + s * 1024); hi[s] = vtr(vp + d * VBS + s * 1024 + 512); }
#pragma unroll
        for (int s = 0; s < 2 * NBK; ++s) { const bf16x8 vf = (bf16x8){lo[s][0], lo[s][1], lo[s][2], lo[s][3], hi[s][0], hi[s][1], hi[s][2], hi[s][3]};
            S.o[d] = __builtin_amdgcn_mfma_f32_32x32x16_bf16(vf, pa[s], S.o[d], 0, 0, 0); }
        __builtin_amdgcn_sched_barrier(0);
    }
}
template <int VBS, bool MASK>
__device__ __forceinline__ void tile_h2(State& S, const bf16x8 (&qr)[8], const LAS unsigned char* Kb, const LAS unsigned char* Vb, const LAS float* ckp, float cq, int dq, int lane) {
    const int r32 = lane & 31, h2 = lane >> 5, kx = (r32 & 7) << 4;
    const f32x16 z16 = (f32x16){0.f, 0.f, 0.f, 0.f, 0.f, 0.f, 0.f, 0.f, 0.f, 0.f, 0.f, 0.f, 0.f, 0.f, 0.f, 0.f};
    f32x16 p[2] = {z16, z16};
    const LAS unsigned char* kp4[4];
#pragma unroll
    for (int j = 0; j < 4; ++j) kp4[j] = Kb + r32 * 256 + ((32 * j + 16 * h2) ^ kx);
#pragma unroll
    for (int nb = 0; nb < 2; ++nb) {
#pragma unroll
        for (int kq = 0; kq < 2; ++kq) { bf16x8 kf[4];
#pragma unroll
            for (int j = 0; j < 4; ++j) kf[j] = *(const LAS bf16x8*)(kp4[j] + kq * 128 + nb * 8192);
#pragma unroll
            for (int j = 0; j < 4; ++j) p[nb] = __builtin_amdgcn_mfma_f32_32x32x16_bf16(kf[j], qr[4 * kq + j], p[nb], 0, 0, 0); }
    }
    const LAS unsigned char* vp = Vb + (4 * h2 + ((lane >> 2) & 3)) * 64 + ((lane >> 4) & 1) * 32 + (lane & 3) * 8;
#pragma unroll
    for (int nb = 0; nb < 2; ++nb) {
        float mx = -__builtin_inff();
#pragma unroll
        for (int g = 0; g < 4; ++g) { const f32x4 ck = *(const LAS f32x4*)(ckp + nb * 32 + 8 * g + 4 * h2);
#pragma unroll
            for (int e = 0; e < 4; ++e) { float s = p[nb][4 * g + e] + (cq - ck[e]);
                if (MASK) { const int kk = nb * 32 + 8 * g + 4 * h2 + e; if (kk > dq) s = -__builtin_inff(); }
                p[nb][4 * g + e] = s; mx = fmaxf(mx, s); } }
        mx = fmaxf(mx, __shfl_xor(mx, 32));
        const float mn = (mx > S.m + 8.0f) ? mx : S.m;
        const float alpha = __builtin_amdgcn_exp2f(S.m - mn); const bool resc = __any(mn != S.m); S.m = mn;
        float ls = 0.f;
#pragma unroll
        for (int i = 0; i < 16; ++i) { const float e = __builtin_amdgcn_exp2f(p[nb][i] - mn); p[nb][i] = e; ls += e; }
        S.l = S.l * alpha + ls;
        if (resc) {
#pragma unroll
            for (int d = 0; d < 4; ++d)
#pragma unroll
                for (int i = 0; i < 16; ++i) S.o[d][i] *= alpha; }
        const bf16x8 pa0 = pack8(p[nb], 0), pa1 = pack8(p[nb], 8);
#pragma unroll
        for (int d = 0; d < 4; ++d) {
            const s16x4 l0 = vtr(vp + d * VBS + (2 * nb) * 1024), h0 = vtr(vp + d * VBS + (2 * nb) * 1024 + 512), l1 = vtr(vp + d * VBS + (2 * nb + 1) * 1024), h1 = vtr(vp + d * VBS + (2 * nb + 1) * 1024 + 512);
            S.o[d] = __builtin_amdgcn_mfma_f32_32x32x16_bf16((bf16x8){l0[0], l0[1], l0[2], l0[3], h0[0], h0[1], h0[2], h0[3]}, pa0, S.o[d], 0, 0, 0);
            S.o[d] = __builtin_amdgcn_mfma_f32_32x32x16_bf16((bf16x8){l1[0], l1[1], l1[2], l1[3], h1[0], h1[1], h1[2], h1[3]}, pa1, S.o[d], 0, 0, 0); }
    }
}
template <int PER, class LD>
__device__ __forceinline__ void cumsum_lds(LAS float* cl, LAS float* scr, int n, int tid, const LD& ld) {
    asm volatile("" : "+v"(tid));
    const int lane = tid & 63, wave = tid >> 6; float v[PER]; float tot = 0.f;
#pragma unroll
    for (int e = 0; e < PER; ++e) { const int i = tid * PER + e; v[e] = i < n ? ld(i) : 0.f; tot += v[e]; }
    float inc = tot;
#pragma unroll
    for (int o = 1; o < 64; o <<= 1) { const float t = __builtin_bit_cast(float, __builtin_amdgcn_ds_bpermute(((lane - o) & 63) << 2, __builtin_bit_cast(int, inc))); if (lane >= o) inc += t; }
    if (lane == 63) scr[wave] = inc;
    __syncthreads();
    float base = inc - tot;
    for (int w = 0; w < wave; ++w) base += scr[w];
#pragma unroll
    for (int e = 0; e < PER; ++e) { base += v[e]; const int i = tid * PER + e; if (i < n) cl[i] = base * LOG2E; }
    __syncthreads();
}

constexpr int P_K = 0, P_V = 32768, P_VBS = 4160, P_VSZ = 4 * P_VBS, P_CL = P_V + 2 * P_VSZ, P_SCR = P_CL + 8448;
constexpr int S_TILE = 16384 + P_VSZ, S_BUF = 2 * S_TILE, S_CL = 2 * S_BUF, S_SCR = S_CL + 8448, S_ML = S_SCR + 64;

__device__ __forceinline__ void attn_phase(const Ctx& c, int l, LAS unsigned char* lds, int G, int bx, int tid) {
    asm volatile("" : "+v"(tid));
    const int lane = tid & 63, wave = __builtin_amdgcn_readfirstlane(tid >> 6), r32 = lane & 31, h2 = lane >> 5;
    const bf16* qb = (const bf16*)(c.ws + WS_QB); const bf16* kb = (const bf16*)(c.ws + WS_KB); const bf16* vb = (const bf16*)(c.ws + WS_VB); bf16* mg = (bf16*)(c.ws + WS_MG); float* sta = stat_ptr(c, ST_A);
#ifndef NO_PROMPT
    for (int item = bx; item < NBAT * NH * 4; item += G) {
        const int b = item >> 5, h = (item >> 2) & 7, pr = item & 3;
        const int nqb = pr == 1 ? 3 : pr == 2 ? 1 : 2;
        LAS float* cl = (LAS float*)(lds + P_CL); const float* lf = c.out + O_LFP + (size_t)l * MP * NH + (size_t)b * SEQ * NH + h;
        cumsum_lds<4>(cl, (LAS float*)(lds + P_SCR), SEQ, tid, [&](int i) { return lf[(size_t)i * NH]; });
        for (int half = 0; half < nqb; ++half) {
            int t_ = tid; asm volatile("" : "+v"(t_));
            const int lane = t_ & 63, r32 = lane & 31, h2 = lane >> 5;
            const int qblk = pr == 0 ? (half ? 3 : 7) : pr == 1 ? (half == 0 ? 6 : half == 1 ? 2 : 1) : pr == 2 ? 5 : (half ? 0 : 4), q0 = qblk * 256, nt = 4 * (qblk + 1), qw = q0 + wave * 32;
            const size_t qrow = (size_t)b * SEQ + qw + r32;
            bf16x8 qr[8];
#pragma unroll
            for (int ks = 0; ks < 8; ++ks) qr[ks] = *(const bf16x8*)(qb + qrow * AW + h * HD + 16 * ks + 8 * h2);
            const float cq = cl[qw + r32];
            State S;
#pragma unroll
            for (int d = 0; d < 4; ++d) S.o[d] = (f32x16){0.f, 0.f, 0.f, 0.f, 0.f, 0.f, 0.f, 0.f, 0.f, 0.f, 0.f, 0.f, 0.f, 0.f, 0.f, 0.f};
            S.m = -1e30f; S.l = 0.f;
            const int krow = 4 * wave + (lane >> 4);
            const bf16* kg = kb + ((size_t)b * SEQ + krow) * AW + h * HD + 8 * ((lane & 15) ^ (krow & 7));
            const bf16* vg = vb + ((size_t)b * SEQ + 32 * (wave & 1) + (lane >> 2)) * AW + h * HD + 32 * (wave >> 1) + 8 * (lane & 3);
            const int kdst = P_K + wave * 1024, vdst = P_V + (wave >> 1) * P_VBS + (wave & 1) * 2048;
#define ATT_STAGE(buf, k0_) do { const size_t o_ = (size_t)(k0_) * AW; \
                __builtin_amdgcn_global_load_lds((const unsigned*)(kg + o_), (LAS unsigned*)(lds + kdst + (buf) * 16384), 16, 0, 0); \
                __builtin_amdgcn_global_load_lds((const unsigned*)(kg + o_ + 32 * AW), (LAS unsigned*)(lds + kdst + (buf) * 16384 + 8192), 16, 0, 0); \
                __builtin_amdgcn_global_load_lds((const unsigned*)(vg + o_), (LAS unsigned*)(lds + vdst + (buf) * P_VSZ), 16, 0, 0); \
                __builtin_amdgcn_global_load_lds((const unsigned*)(vg + o_ + 16 * AW), (LAS unsigned*)(lds + vdst + (buf) * P_VSZ + 1024), 16, 0, 0); } while (0)
            ATT_STAGE(0, 0);
            asm volatile("s_waitcnt vmcnt(0)" ::: "memory"); __syncthreads();
            for (int t = 0; t < nt; ++t) {
                const int cur = t & 1, k0 = 64 * t;
                if (t + 1 < nt) ATT_STAGE(cur ^ 1, k0 + 64);
                if (k0 <= qw + 31) {
                    const LAS unsigned char* Kb = lds + P_K + cur * 16384; const LAS unsigned char* Vb = lds + P_V + cur * P_VSZ;
                    if (k0 + 63 > qw) tile_h2<P_VBS, true>(S, qr, Kb, Vb, cl + k0, cq, qw + r32 - k0, lane);
                    else tile_h2<P_VBS, false>(S, qr, Kb, Vb, cl + k0, cq, 0, lane);
                }
                asm volatile("s_waitcnt vmcnt(0)" ::: "memory"); __syncthreads();
            }
#undef ATT_STAGE
            const float lt = S.l + __shfl_xor(S.l, 32), inv = 1.0f / lt; float ss = 0.f;
            bf16* op = mg + qrow * D + h * HD + 4 * h2;
#pragma unroll
            for (int d = 0; d < 4; ++d)
#pragma unroll
                for (int g = 0; g < 4; ++g) { const f32x4 v = (f32x4){S.o[d][4 * g] * inv, S.o[d][4 * g + 1] * inv, S.o[d][4 * g + 2] * inv, S.o[d][4 * g + 3] * inv}; ss += sumsq4(v); st_bf4(op + 32 * d + 8 * g, v); }
            ss += __shfl_xor(ss, 32); if (h2 == 0) sta[qrow * SS + h] = ss;
        }
    }
#endif
#ifndef NO_SAMPLE
    for (int pit = bx; pit < NBAT * NH * 4; pit += G) {
        if ((pit & 3) < 2) continue;
        const int item = (pit >> 2) * 2 + (pit & 1), b = item >> 3, h = item & 7;
        LAS float* cl = (LAS float*)(lds + P_CL);
        const float* lfc = c.in[4] + ((size_t)l * DBAT + b) * PAST * NH + h; const float* lfn = c.out + O_LFS + ((size_t)l * MS + b * DSEQ) * NH + h;
        cumsum_lds<5>(cl, (LAS float*)(lds + P_SCR), PAST + DSEQ, tid, [&](int i) { return i < PAST ? lfc[(size_t)i * NH] : lfn[(size_t)(i - PAST) * NH]; });
        int t_ = tid; asm volatile("" : "+v"(t_));
        const int lane = t_ & 63, r32 = lane & 31, h2 = lane >> 5;
        const int qi = r32 & 15; const size_t qrow = (size_t)MP + b * DSEQ + qi;
        bf16x8 qr[8];
#pragma unroll
        for (int ks = 0; ks < 8; ++ks) qr[ks] = *(const bf16x8*)(qb + qrow * AW + h * HD + 16 * ks + 8 * h2);
        const float cq = cl[PAST + qi];
        State S;
#pragma unroll
        for (int d = 0; d < 4; ++d) S.o[d] = (f32x16){0.f, 0.f, 0.f, 0.f, 0.f, 0.f, 0.f, 0.f, 0.f, 0.f, 0.f, 0.f, 0.f, 0.f, 0.f, 0.f};
        S.m = -1e30f; S.l = 0.f;
        const float* kg0 = c.in[2] + (((size_t)l * DBAT + b) * PAST) * AW + h * HD; const float* vg0 = c.in[3] + (((size_t)l * DBAT + b) * PAST) * AW + h * HD;
        const bf16* kn0 = kb + ((size_t)MP + b * DSEQ) * AW + h * HD; const bf16* vn0 = vb + ((size_t)MP + b * DSEQ) * AW + h * HD;
#define SMP_LOAD(R, tn) do { int x_ = t_ - 128; asm volatile("" : "+v"(x_)); \
            _Pragma("unroll") for (int ps = 0; ps < 6; ++ps) { const int ci = x_ + 384 * ps; R[2 * ps] = (f32x4){0.f, 0.f, 0.f, 0.f}; R[2 * ps + 1] = R[2 * ps]; if (ci < 2048) { const int isv = ci >> 10, row = (ci >> 4) & 63, ch = ci & 15; \
                if ((tn) < 32) { const float* src = (isv ? vg0 : kg0) + (size_t)(64 * (tn) + row) * AW + 8 * ch; R[2 * ps] = *(const f32x4*)src; R[2 * ps + 1] = *(const f32x4*)(src + 4); } \
                else if (row < DSEQ) R[2 * ps] = __builtin_bit_cast(f32x4, *(const u32x4*)((isv ? vn0 : kn0) + (size_t)row * AW + 8 * ch)); } } } while (0)
#define SMP_WRITE(R, tn, buf) do { int x_ = t_ - 128; asm volatile("" : "+v"(x_)); \
            _Pragma("unroll") for (int ps = 0; ps < 6; ++ps) { const int ci = x_ + 384 * ps; if (ci < 2048) { const int isv = ci >> 10, row = (ci >> 4) & 63, ch = ci & 15; u32x4 w_; \
                if ((tn) < 32) { w_.x = cvtpk(R[2 * ps].x, R[2 * ps].y); w_.y = cvtpk(R[2 * ps].z, R[2 * ps].w); w_.z = cvtpk(R[2 * ps + 1].x, R[2 * ps + 1].y); w_.w = cvtpk(R[2 * ps + 1].z, R[2 * ps + 1].w); } \
                else w_ = __builtin_bit_cast(u32x4, R[2 * ps]); \
                if (isv) *(LAS u32x4*)(lds + P_V + (buf) * P_VSZ + (ch >> 2) * P_VBS + row * 64 + (ch & 3) * 16) = w_; else *(LAS u32x4*)(lds + P_K + (buf) * 16384 + kswz(row, ch * 16)) = w_; } } } while (0)
#define SMP_BAR() do { asm volatile("s_waitcnt lgkmcnt(0)" ::: "memory"); __builtin_amdgcn_s_barrier(); asm volatile("" ::: "memory"); } while (0)
        if (wave < 2) {
            SMP_BAR();
            for (int t = 0; t < 33; ++t) { const int cur = t & 1;
                const LAS unsigned char* Kb = lds + P_K + cur * 16384 + wave * 8192; const LAS unsigned char* Vb = lds + P_V + cur * P_VSZ + wave * 2048;
                if (t < 32) tile<1, P_VBS, false>(S, qr, Kb, Vb, cl + 64 * t + 32 * wave, cq, 0, lane);
                else if (wave == 0) tile<1, P_VBS, true>(S, qr, Kb, Vb, cl + PAST, cq, qi, lane);
                SMP_BAR(); }
        } else {
            f32x4 RA[12], RB[12];
            SMP_LOAD(RA, 0); SMP_WRITE(RA, 0, 0); SMP_LOAD(RA, 1); SMP_LOAD(RB, 2);
            SMP_BAR();
#define SMP_STEP(R, t) do { if ((t) + 1 < 33) SMP_WRITE(R, (t) + 1, ((t) & 1) ^ 1); if ((t) + 3 < 33) SMP_LOAD(R, (t) + 3); SMP_BAR(); } while (0)
            for (int t = 0; t < 32; t += 2) { SMP_STEP(RA, t); SMP_STEP(RB, t + 1); }
            SMP_STEP(RA, 32);
        }
        asm volatile("s_waitcnt vmcnt(0)" ::: "memory");
#undef SMP_BAR
#undef SMP_STEP
#undef SMP_LOAD
#undef SMP_WRITE
        const float lt = S.l + __shfl_xor(S.l, 32);
        LAS float* cmb = (LAS float*)lds; LAS float* ml = (LAS float*)(lds + 32768);
        int u_ = tid; asm volatile("" : "+v"(u_));
        { const int r32 = u_ & 31, h2 = (u_ >> 5) & 1;
        if (wave < 2 && r32 < 16) {
#pragma unroll
            for (int d = 0; d < 4; ++d)
#pragma unroll
                for (int g = 0; g < 4; ++g) *(LAS f32x4*)(cmb + (wave * 16 + r32) * 128 + 32 * d + 8 * g + 4 * h2) = (f32x4){S.o[d][4 * g], S.o[d][4 * g + 1], S.o[d][4 * g + 2], S.o[d][4 * g + 3]};
            if (h2 == 0) { ml[(wave * 16 + r32) * 2] = S.m; ml[(wave * 16 + r32) * 2 + 1] = lt; }
        } }
        __syncthreads();
        { const int q = u_ >> 5, d4 = (u_ & 31) * 4;
          const float m0 = ml[q * 2], m1 = ml[(16 + q) * 2], M = fmaxf(m0, m1), f0 = __builtin_amdgcn_exp2f(m0 - M), f1 = __builtin_amdgcn_exp2f(m1 - M);
          const float L = ml[q * 2 + 1] * f0 + ml[(16 + q) * 2 + 1] * f1;
          f32x4 acc = *(const LAS f32x4*)(cmb + q * 128 + d4) * f0 + *(const LAS f32x4*)(cmb + (16 + q) * 128 + d4) * f1;
          const float inv = 1.0f / L; acc = acc * inv;
          const size_t orow = (size_t)MP + b * DSEQ + q; st_bf4(mg + orow * D + h * HD + d4, acc);
          float ss = sumsq4(acc);
#pragma unroll
          for (int k = 1; k < 32; k <<= 1) ss += __builtin_bit_cast(float, __builtin_amdgcn_ds_bpermute(((u_ & 63) ^ k) << 2, __builtin_bit_cast(int, ss)));
          if ((u_ & 31) == 0) sta[orow * SS + h] = ss; }
        __syncthreads();
    }
#endif
}
}

namespace ssm {
constexpr int IMB = 6144, IMW = 2 * IMB, E_OFF = 8 * IMW;
struct Cx { float r0, i0, r1, i1; };
template <bool OUT>
__device__ __forceinline__ void chunk(const bf16* ub, bf16* gs, size_t ubase0, size_t ubase1, size_t grow0, size_t grow1, int t0, int nsteps, const bf16x8 (&bfr)[4], const bf16x8 (&cfr)[4],
                                      float ar0, float ai0, float ar1, float ai1, f32x4 dsk, Cx& x, LAS unsigned char* img, int lane) {
    asm volatile("" : "+v"(lane));
    const int r32 = lane & 31, h2 = lane >> 5, quad = lane >> 4, c16 = lane & 15;
    const int bsel = (r32 >> 2) & 1, ti = (r32 & 3) + 4 * (r32 >> 3);
    const bf16* up = ub + (bsel ? ubase1 : ubase0) + (size_t)(t0 + ti) * 16 + 8 * h2;
    LAS unsigned char* wp = img + (r32 >> 3) * 384 + (r32 & 7) * 32 + 8 * h2;
    const LAS unsigned char* rp = img + quad * 384 + ((lane >> 2) & 3) * 32 + (lane & 3) * 8;
    const f32x16 z16 = (f32x16){0.f, 0.f, 0.f, 0.f, 0.f, 0.f, 0.f, 0.f, 0.f, 0.f, 0.f, 0.f, 0.f, 0.f, 0.f, 0.f};
    bf16x8 ufn = *(const bf16x8*)up;
    for (int s = 0; s < nsteps; ++s) {
        const bf16x8 uf = ufn;
        if (s + 1 < nsteps) ufn = *(const bf16x8*)(up + (size_t)(s + 1) * 256);
        u32x2 uw[2];
        if (OUT) {
#pragma unroll
            for (int mb = 0; mb < 2; ++mb) { const int tok = t0 + 16 * s + 4 * (2 * mb + (c16 >> 3)) + (c16 & 3); const size_t ubq = ((c16 >> 2) & 1) ? ubase1 : ubase0;
                uw[mb] = *(const u32x2*)(ub + ubq + (size_t)tok * 16 + 4 * quad); }
        }
        f32x16 a0 = __builtin_amdgcn_mfma_f32_32x32x16_bf16(uf, bfr[0], z16, 0, 0, 0), a1 = __builtin_amdgcn_mfma_f32_32x32x16_bf16(uf, bfr[1], z16, 0, 0, 0);
        f32x16 a2 = __builtin_amdgcn_mfma_f32_32x32x16_bf16(uf, bfr[2], z16, 0, 0, 0), a3 = __builtin_amdgcn_mfma_f32_32x32x16_bf16(uf, bfr[3], z16, 0, 0, 0);
#pragma unroll
        for (int i = 0; i < 16; ++i) {
            const float n0r = ar0 * x.r0 - ai0 * x.i0 + a0[i], n0i = ar0 * x.i0 + ai0 * x.r0 + a2[i]; x.r0 = n0r; x.i0 = n0i;
            const float n1r = ar1 * x.r1 - ai1 * x.i1 + a1[i], n1i = ar1 * x.i1 + ai1 * x.r1 + a3[i]; x.r1 = n1r; x.i1 = n1i;
            if (OUT) { a0[i] = n0r; a2[i] = n0i; a1[i] = n1r; a3[i] = n1i; }
        }
        if (OUT) {
#pragma unroll
            for (int gq = 0; gq < 4; ++gq) { const int o = (gq >> 1) * IMB + (gq & 1) * 16;
                u32x2 w; w.x = cvtpk(a0[4 * gq], a0[4 * gq + 1]); w.y = cvtpk(a0[4 * gq + 2], a0[4 * gq + 3]); *(LAS u32x2*)(wp + o) = w;
                w.x = cvtpk(a1[4 * gq], a1[4 * gq + 1]); w.y = cvtpk(a1[4 * gq + 2], a1[4 * gq + 3]); *(LAS u32x2*)(wp + o + 1536) = w;
                w.x = cvtpk(a2[4 * gq], a2[4 * gq + 1]); w.y = cvtpk(a2[4 * gq + 2], a2[4 * gq + 3]); *(LAS u32x2*)(wp + o + 3072) = w;
                w.x = cvtpk(a3[4 * gq], a3[4 * gq + 1]); w.y = cvtpk(a3[4 * gq + 2], a3[4 * gq + 3]); *(LAS u32x2*)(wp + o + 4608) = w; }
            asm volatile("s_waitcnt lgkmcnt(0)" ::: "memory");
#pragma unroll
            for (int mb = 0; mb < 2; ++mb) {
                f32x4 y = (f32x4){0.f, 0.f, 0.f, 0.f};
#pragma unroll
                for (int ks = 0; ks < 4; ++ks) { const s16x4 lo = att::vtr(rp + mb * IMB + ks * 1536), hi = att::vtr(rp + mb * IMB + ks * 1536 + 128);
                    const bf16x8 xf = (bf16x8){lo[0], lo[1], lo[2], lo[3], hi[0], hi[1], hi[2], hi[3]};
                    y = __builtin_amdgcn_mfma_f32_16x16x32_bf16(cfr[ks], xf, y, 0, 0, 0); }
                const int tok = t0 + 16 * s + 4 * (2 * mb + (c16 >> 3)) + (c16 & 3); const size_t grq = ((c16 >> 2) & 1) ? grow1 : grow0;
                const float v0 = gelu_tanh_(y[0] + dsk.x * bflo(uw[mb].x)), v1 = gelu_tanh_(y[1] + dsk.y * bfhi(uw[mb].x)), v2 = gelu_tanh_(y[2] + dsk.z * bflo(uw[mb].y)), v3 = gelu_tanh_(y[3] + dsk.w * bfhi(uw[mb].y));
                u32x2 o; o.x = cvtpk(v0, v1); o.y = cvtpk(v2, v3); *(u32x2*)(gs + (grq + tok) * SW + 4 * quad) = o;
            }
            asm volatile("s_waitcnt lgkmcnt(0)" ::: "memory");
        }
    }
}
__device__ __forceinline__ void ssm_phase(const Ctx& c, int l, LAS unsigned char* lds, int G, int bx, int tid) {
    asm volatile("" : "+v"(tid));
    const int lane = tid & 63, wave = __builtin_amdgcn_readfirstlane(tid >> 6), r32 = lane & 31, h2 = lane >> 5, quad = lane >> 4, c16 = lane & 15;
    const Lw w = layer_w(c, l); const bf16* ub = (const bf16*)(c.ws + WS_UB); bf16* gs = (bf16*)(c.ws + WS_GS);
    LAS unsigned char* img = lds + wave * IMW; LAS float* E = (LAS float*)(lds + E_OFF);
    for (int item = bx; item < NG * 4 + NG; item += G) {
        const bool smp = item >= NG * 4; const int g = smp ? item - NG * 4 : item >> 2, bp = smp ? wave : item & 3, b0 = 2 * bp, T = smp ? DSEQ : SEQ;
        bf16x8 bfr[4], cfr[4];
#pragma unroll
        for (int nb = 0; nb < 4; ++nb) bfr[nb] = *(const bf16x8*)(w.bcat + ((size_t)g * 128 + 32 * nb + r32) * 16 + 8 * h2);
#pragma unroll
        for (int ks = 0; ks < 4; ++ks) cfr[ks] = *(const bf16x8*)(w.ccat + ((size_t)g * 16 + c16) * 128 + 32 * ks + 8 * quad);
        const float ar0 = w.abr[g * NP + r32], ai0 = w.abi[g * NP + r32], ar1 = w.abr[g * NP + 32 + r32], ai1 = w.abi[g * NP + 32 + r32];
        const f32x4 dsk = *(const f32x4*)(c.in[21] + l * SW + g * 16 + 4 * quad);
        const size_t ub0 = (smp ? UB_S_OFF : 0) + ((size_t)b0 * NG + g) * T * 16, ub1 = ub0 + (size_t)NG * T * 16;
        const size_t gr0 = smp ? (size_t)MP + b0 * DSEQ : (size_t)b0 * SEQ, gr1 = gr0 + T;
        bf16* gsg = gs + g * 16;
        Cx x; x.r0 = 0.f; x.i0 = 0.f; x.r1 = 0.f; x.i1 = 0.f;
        if (!smp) {
            chunk<false>(ub, gsg, ub0, ub1, gr0, gr1, wave * 256, 16, bfr, cfr, ar0, ai0, ar1, ai1, dsk, x, img, lane);
            E[(wave * 4 + 0) * 64 + lane] = x.r0; E[(wave * 4 + 1) * 64 + lane] = x.i0; E[(wave * 4 + 2) * 64 + lane] = x.r1; E[(wave * 4 + 3) * 64 + lane] = x.i1;
            __syncthreads();
            float p0r = ar0, p0i = ai0, p1r = ar1, p1i = ai1;
#pragma unroll
            for (int k = 0; k < 8; ++k) { const float t0r = p0r * p0r - p0i * p0i, t0i = (p0r + p0r) * p0i, t1r = p1r * p1r - p1i * p1i, t1i = (p1r + p1r) * p1i; p0r = t0r; p0i = t0i; p1r = t1r; p1i = t1i; }
            x.r0 = 0.f; x.i0 = 0.f; x.r1 = 0.f; x.i1 = 0.f;
            for (int ww = 0; ww < wave; ++ww) {
                const float e0r = E[(ww * 4 + 0) * 64 + lane], e0i = E[(ww * 4 + 1) * 64 + lane], e1r = E[(ww * 4 + 2) * 64 + lane], e1i = E[(ww * 4 + 3) * 64 + lane];
                const float n0r = p0r * x.r0 - p0i * x.i0 + e0r, n0i = p0r * x.i0 + p0i * x.r0 + e0i, n1r = p1r * x.r1 - p1i * x.i1 + e1r, n1i = p1r * x.i1 + p1i * x.r1 + e1i;
                x.r0 = n0r; x.i0 = n0i; x.r1 = n1r; x.i1 = n1i; }
            chunk<true>(ub, gsg, ub0, ub1, gr0, gr1, wave * 256, 16, bfr, cfr, ar0, ai0, ar1, ai1, dsk, x, img, lane);
            __syncthreads();
        } else {
            const size_t so = (((size_t)l * DBAT + b0 + h2) * NG + g) * NP + r32;
            x.r0 = c.in[5][so]; x.i0 = c.in[6][so]; x.r1 = c.in[5][so + 32]; x.i1 = c.in[6][so + 32];
            chunk<true>(ub, gsg, ub0, ub1, gr0, gr1, 0, 1, bfr, cfr, ar0, ai0, ar1, ai1, dsk, x, img, lane);
        }
        if (smp || wave == 7) {
            float* sre = c.out + (smp ? O_SRS + (((size_t)l * DBAT + b0 + h2) * NG + g) * NP : O_SRP + (((size_t)l * NBAT + b0 + h2) * NG + g) * NP);
            float* sim = c.out + (smp ? O_SIS + (((size_t)l * DBAT + b0 + h2) * NG + g) * NP : O_SIP + (((size_t)l * NBAT + b0 + h2) * NG + g) * NP);
            sre[r32] = x.r0; sre[r32 + 32] = x.r1; sim[r32] = x.i0; sim[r32 + 32] = x.i1;
        }
    }
}
}

constexpr int SKB_STRIDE = 528, SKB_BUF = 64 * SKB_STRIDE;
template <int NB, bool PAIR, class F>
__device__ __forceinline__ void sk_gemm(LAS unsigned char* lds, const GArgs& g, const F& f, int G, int bx, int tid) {
    asm volatile("" : "+v"(tid));
    const int lane = tid & 63, wave = __builtin_amdgcn_readfirstlane(tid >> 6), r32 = lane & 31, h2 = lane >> 5, nsc = g.K / 256;
    const int scol = tid >> 3, sp = tid & 7;
    const int nunits = g.nrt * g.nct;
    __syncthreads();
    for (int u = bx; u < nunits; u += G) {
        const int tr = u / g.nct, tc = u % g.nct, row = g.r0 + 256 * tr + 32 * wave + r32;
        int nb0, nb1, colbase;
        if (PAIR) { nb0 = 256 * (tc >> 2) + 32 * (tc & 3); nb1 = nb0 + 128; colbase = 32 * tc; } else { nb0 = 32 * NB * tc; nb1 = nb0 + 32; colbase = nb0; }
        const bf16* ap = g.A + (size_t)row * g.lda + 8 * h2;
        const bf16* bg = g.Bt + (size_t)((scol < 32 ? nb0 : nb1 - 32) + scol) * g.ldb + 8 * sp;
        const bool stg = NB == 2 || scol < 32;
        LAS unsigned char* bw = lds + scol * SKB_STRIDE + sp * 16;
        const LAS unsigned char* br = lds + r32 * SKB_STRIDE + 16 * h2;
        f32x16 acc0 = {}, acc1 = {};
        bf16x8 a[16], an[16]; u32x4 bs[4], bs2[4];
#pragma unroll
        for (int i = 0; i < 4; ++i) bs[i] = stg ? *(const u32x4*)(bg + 64 * i) : (u32x4){0u, 0u, 0u, 0u};
#pragma unroll
        for (int j = 0; j < 16; ++j) a[j] = *(const bf16x8*)(ap + 16 * j);
        if (stg) {
#pragma unroll
            for (int i = 0; i < 4; ++i) *(LAS u32x4*)(bw + 128 * i) = bs[i]; }
        if (stg && nsc > 1) {
#pragma unroll
            for (int i = 0; i < 4; ++i) bs[i] = *(const u32x4*)(bg + 256 + 64 * i); }
        __syncthreads();
        const int cmid = F::MID ? g.kmid / 256 : -1;
        for (int sc = 0; sc < nsc; ++sc) {
            const int cur = sc & 1;
            if (sc + 2 < nsc && stg) {
#pragma unroll
                for (int i = 0; i < 4; ++i) bs2[i] = *(const u32x4*)(bg + 256 * (sc + 2) + 64 * i); }
            if (sc + 1 < nsc) {
#pragma unroll
                for (int j = 0; j < 16; ++j) an[j] = *(const bf16x8*)(ap + 256 * (sc + 1) + 16 * j); }
            if (F::MID && sc == cmid) { const float sm = f.mid_scale(row);
#pragma unroll
                for (int i = 0; i < 16; ++i) { acc0[i] *= sm; acc1[i] *= sm; } }
#pragma unroll
            for (int j = 0; j < 16; ++j) {
                const bf16x8 b0 = *(const LAS bf16x8*)(br + cur * SKB_BUF + 32 * j);
                acc0 = __builtin_amdgcn_mfma_f32_32x32x16_bf16(b0, a[j], acc0, 0, 0, 0);
                if (NB == 2) { const bf16x8 b1 = *(const LAS bf16x8*)(br + cur * SKB_BUF + 32 * SKB_STRIDE + 32 * j); acc1 = __builtin_amdgcn_mfma_f32_32x32x16_bf16(b1, a[j], acc1, 0, 0, 0); }
            }
            if (sc + 1 < nsc) {
                if (stg) {
#pragma unroll
                    for (int i = 0; i < 4; ++i) { *(LAS u32x4*)(bw + (cur ^ 1) * SKB_BUF + 128 * i) = bs[i]; bs[i] = bs2[i]; } }
#pragma unroll
                for (int j = 0; j < 16; ++j) a[j] = an[j]; }
            __syncthreads();
        }
        const float rs = f.row_begin(row); float ss = 0.f;
        if constexpr (PAIR) {
#pragma unroll
            for (int gq = 0; gq < 4; ++gq) ss += f.apply2(rs, row, colbase + 8 * gq + 4 * h2, (f32x4){acc0[4 * gq], acc0[4 * gq + 1], acc0[4 * gq + 2], acc0[4 * gq + 3]}, (f32x4){acc1[4 * gq], acc1[4 * gq + 1], acc1[4 * gq + 2], acc1[4 * gq + 3]});
        } else {
#pragma unroll
            for (int gq = 0; gq < 4; ++gq) ss += f.apply(rs, row, colbase + 8 * gq + 4 * h2, (f32x4){acc0[4 * gq], acc0[4 * gq + 1], acc0[4 * gq + 2], acc0[4 * gq + 3]});
            if (NB == 2) {
#pragma unroll
                for (int gq = 0; gq < 4; ++gq) ss += f.apply(rs, row, colbase + 32 + 8 * gq + 4 * h2, (f32x4){acc1[4 * gq], acc1[4 * gq + 1], acc1[4 * gq + 2], acc1[4 * gq + 3]});
            }
        }
        if (F::STATS) { ss += __shfl_xor(ss, 32); if (h2 == 0) f.st[(size_t)row * SS + tc] = ss; }
    }
}

constexpr int SQ_PITCH = 528, SQ_A = 64 * SQ_PITCH, SQ_BUF = 96 * SQ_PITCH, SQ_PP = 36;
#define SQ_BAR() asm volatile("s_waitcnt lgkmcnt(0)\n\ts_barrier" ::: "memory")
template <class F>
__device__ __forceinline__ void sq2_gemm(LAS unsigned char* lds, const GArgs& g, const F& f, int G, int bx, int tid) {
    asm volatile("" : "+v"(tid));
    const int lane = tid & 63, wave = __builtin_amdgcn_readfirstlane(tid >> 6), r32 = lane & 31, h2 = lane >> 5, rb = wave & 1, kq = wave >> 1;
    const int nsc = g.K / 256, nunits = g.nrt * g.nct;
    const int srow = tid >> 5, sp = tid & 31;
    const int cmid = F::MID ? g.kmid / 256 : -1;
    __syncthreads();
    for (int u = bx; u < nunits; u += G) {
        const int tc = u / g.nrt, rg = u % g.nrt, row0 = g.r0 + 64 * rg, nb0 = 32 * tc;
        const bf16* ag = g.A + (size_t)(row0 + srow) * g.lda + 8 * sp;
        const bf16* bg = g.Bt + (size_t)(nb0 + srow) * g.ldb + 8 * sp;
        const size_t astep = (size_t)16 * g.lda, bstep = (size_t)16 * g.ldb;
        LAS unsigned char* sw = lds + srow * SQ_PITCH + sp * 16;
        const LAS unsigned char* ar = lds + (32 * rb + r32) * SQ_PITCH + 128 * kq + 16 * h2;
        const LAS unsigned char* br = lds + SQ_A + r32 * SQ_PITCH + 128 * kq + 16 * h2;
        const int er = tid >> 3, cq = tid & 7, grow = row0 + er;
        const float rs = f.row_begin(grow);
        f32x16 acc = {};
        u32x4 s0[6], s1[6];
#define SQ_LOAD(s, c) do { _Pragma("unroll") for (int i = 0; i < 4; ++i) s[i] = *(const u32x4*)(ag + i * astep + 256 * (c)); \
                           _Pragma("unroll") for (int i = 0; i < 2; ++i) s[4 + i] = *(const u32x4*)(bg + i * bstep + 256 * (c)); } while (0)
#define SQ_STORE(s, b) do { _Pragma("unroll") for (int i = 0; i < 4; ++i) *(LAS u32x4*)(sw + (b) * SQ_BUF + i * 16 * SQ_PITCH) = s[i]; \
                            _Pragma("unroll") for (int i = 0; i < 2; ++i) *(LAS u32x4*)(sw + (b) * SQ_BUF + SQ_A + i * 16 * SQ_PITCH) = s[4 + i]; } while (0)
#define SQ_COMPUTE(b, c) do { if (F::MID && (c) == cmid) { const float sm = f.mid_scale(row0 + 32 * rb + r32); _Pragma("unroll") for (int i = 0; i < 16; ++i) acc[i] *= sm; } \
        _Pragma("unroll") for (int j = 0; j < 4; ++j) { const bf16x8 a = *(const LAS bf16x8*)(ar + (b) * SQ_BUF + 32 * j); const bf16x8 w = *(const LAS bf16x8*)(br + (b) * SQ_BUF + 32 * j); \
            acc = __builtin_amdgcn_mfma_f32_32x32x16_bf16(w, a, acc, 0, 0, 0); } } while (0)
        SQ_LOAD(s0, 0);
        if (nsc > 1) SQ_LOAD(s1, 1);
        SQ_STORE(s0, 0);
        if (nsc > 2) SQ_LOAD(s0, 2);
        SQ_BAR();
        for (int c = 0; c < nsc; c += 2) {
            SQ_COMPUTE(0, c);
            if (c + 1 < nsc) { SQ_STORE(s1, 1); if (c + 3 < nsc) SQ_LOAD(s1, c + 3); }
            SQ_BAR();
            if (c + 1 >= nsc) break;
            SQ_COMPUTE(1, c + 1);
            if (c + 2 < nsc) { SQ_STORE(s0, 0); if (c + 4 < nsc) SQ_LOAD(s0, c + 4); }
            SQ_BAR();
        }
#undef SQ_LOAD
#undef SQ_STORE
#undef SQ_COMPUTE
        LAS float* P = (LAS float*)lds;
#pragma unroll
        for (int gq = 0; gq < 4; ++gq) *(LAS f32x4*)(P + ((kq * 64 + 32 * rb + r32) * SQ_PP + 8 * gq + 4 * h2)) = (f32x4){acc[4 * gq], acc[4 * gq + 1], acc[4 * gq + 2], acc[4 * gq + 3]};
        __syncthreads();
        {
            const LAS float* pr = P + er * SQ_PP + 4 * cq;
            const f32x4 v = (*(const LAS f32x4*)pr + *(const LAS f32x4*)(pr + 64 * SQ_PP)) + (*(const LAS f32x4*)(pr + 128 * SQ_PP) + *(const LAS f32x4*)(pr + 192 * SQ_PP));
            float ss = f.apply(rs, grow, nb0 + 4 * cq, v);
            if (F::STATS) { ss += __shfl_xor(ss, 1); ss += __shfl_xor(ss, 2); ss += __shfl_xor(ss, 4); if (cq == 0) f.st[(size_t)grow * SS + tc] = ss; }
        }
        __syncthreads();
    }
}


__device__ __forceinline__ Ctx ctx_from_kernarg() {
    Ctx c{};
#if defined(__HIP_DEVICE_COMPILE__)
    typedef const __attribute__((address_space(4))) unsigned long long* kptr_t;
    kptr_t kp = (kptr_t)__builtin_amdgcn_kernarg_segment_ptr(); asm volatile("" : "+s"(kp));
#pragma unroll
    for (int i = 0; i < 34; ++i) c.in[i] = (const float*)(GAS const float*)kp[i];
    c.out = (float*)(GAS float*)kp[34]; c.ws = (unsigned char*)(GAS unsigned char*)kp[35];
#endif
    return c;
}

constexpr int CW_BAR = 4096;
constexpr int LDS_BYTES = 155648;
constexpr int RED_OFF = 147456;
constexpr int MISC_OFF = 153600;
constexpr int MTAB_OFF = 151552;
__global__ __launch_bounds__(512, 2) void mega(Ctx c0) {
    extern __shared__ __attribute__((aligned(16))) unsigned char lds_raw[];
    LAS unsigned char* lds = (LAS unsigned char*)lds_raw; LAS float* red = (LAS float*)(lds + RED_OFF);
    const int G0 = gridDim.x, bx0 = blockIdx.x, wave0 = __builtin_amdgcn_readfirstlane(threadIdx.x >> 6);
#define LANE_ID() ({ int _l; asm volatile("v_mbcnt_lo_u32_b32 %0, -1, 0\n\tv_mbcnt_hi_u32_b32 %0, -1, %0" : "=v"(_l)); _l; })
    volatile LAS unsigned* misc = (volatile LAS unsigned*)(lds + MISC_OFF);
    if (threadIdx.x < 64) misc[threadIdx.x] = 0u;
    __syncthreads();
    (void)xcd_barrier_post((unsigned*)(c0.ws + WS_CTL) + CW_BAR, misc + 8);
#define GRID_SYNC() do { GAS unsigned char* _w = (GAS unsigned char*)ctx_from_kernarg().ws; XcdBarrier _b; _b.bar = (unsigned*)((unsigned char*)_w + WS_CTL) + CW_BAR; _b.x = xb_xcc_id(); _b.st = misc + 8; xcd_barrier(_b); } while (0)
#define PHASE_CTX int bx = bx0, G = G0; asm volatile("" : "+s"(bx), "+s"(G)); const int lane = LANE_ID(), wave = wave0, tid = wave * 64 + lane, gw = bx * 8 + wave, ngw = G * 8; (void)tid; (void)gw; (void)ngw; \
    Ctx c = ctx_from_kernarg();     \
    const Lw w = layer_w(c, l); (void)w; \
    bf16* xb = (bf16*)(c.ws + WS_XB); float* hf = (float*)(c.ws + WS_HF); bf16* hb = (bf16*)(c.ws + WS_HB); bf16* pp = (bf16*)(c.ws + WS_PP); bf16* pb = (bf16*)(c.ws + WS_PB) + (size_t)l * MT * PLE; \
    bf16* qb = (bf16*)(c.ws + WS_QB); bf16* vb = (bf16*)(c.ws + WS_VB); bf16* ub = (bf16*)(c.ws + WS_UB); bf16* gs = (bf16*)(c.ws + WS_GS); bf16* mg = (bf16*)(c.ws + WS_MG); bf16* act = (bf16*)(c.ws + WS_ACT); \
    (void)xb; (void)hf; (void)hb; (void)pp; (void)pb; (void)qb; (void)vb; (void)ub; (void)gs; (void)mg; (void)act;
    { const int lane = LANE_ID(), wave = wave0; p0_prologue(c0, lds, bx0 * 8 + wave, G0 * 8, wave, lane); }
    GRID_SYNC();
#define STAG(it) (((it) == 0) == ((bx0 & 1) == 0))
    for (int l = 0; l < NL; ++l) {
        const int nsxP = l == 0 ? 1 : D / 256, nsxS = l == 0 ? 1 : D / 32;
        { PHASE_CTX EpiIn e{stat_ptr(c, ST_X), nsxP, nsxS, nullptr, qb, vb, ub, c.out + O_KP + (size_t)l * MP * AW, c.out + O_KS + (size_t)l * MS * AW, c.out + O_VP + (size_t)l * MP * AW, c.out + O_VS + (size_t)l * MS * AW, (bf16*)(c.ws + WS_KB), c.in[12] + l * HD, c.in[13] + l * HD};
          EpiF ef{stat_ptr(c, ST_X), nsxP, nsxS, nullptr, c.in[11] + l * NH, c.out + O_LFP + (size_t)l * MP * NH, c.out + O_LFS + (size_t)l * MS * NH};
          const int ord = (bx0 & 3) == 0 ? 0x24 : (bx0 & 3) == 1 ? 0x12 : (bx0 & 3) == 2 ? 0x18 : 0x09;
          for (int it = 0; it < 3; ++it) {
              const int part = (ord >> (2 * it)) & 3;
              if (part == 0) { GArgs g{xb, D, w.win, D, D, MP, 4, 4096 / 32, 0}; sq2_gemm(lds, g, e, G, bx, tid); }
              else if (part == 1) { GArgs gf{xb, D, w.wf, D, D, 0, MP / 64, 1, 0}; sq2_gemm(lds, gf, ef, G, G - 1 - bx, tid); }
              else { pg8::Gemm gg{xb, w.win, MP, 4096, D}; pg8::StaticOrder S; S.init(MP, 4096, G, bx); pg8::gemm_phase<false>(lds, red, gg, S, e, tid); }
          } }
        GRID_SYNC();
        { PHASE_CTX ssm::ssm_phase(c, l, lds, G, bx, tid); }
        { PHASE_CTX qknorm_rows(c, l, gw, ngw, lane); flogit_rows(c, l, ngw - 1 - gw, ngw, lane, nsxS); }
        GRID_SYNC();
        { PHASE_CTX att::attn_phase(c, l, lds, G, bx, tid); }
        { PHASE_CTX EpiGlu e{stat_ptr(c, ST_S), c.in[23] + l * SW, gs, mg};
          GArgs g{gs, SW, w.wglu, SW, SW, MP, 4, SW / 32, 0}; sq2_gemm(lds, g, e, G, bx, tid);
          pg8::Gemm gg{gs, w.wglu, MP, SW, SW}; pg8::StaticOrder S; S.init(MP, SW, G, bx); pg8::gemm_phase<false>(lds, red, gg, S, e, tid); }
        GRID_SYNC();
        { PHASE_CTX LAS float* mtab = (LAS float*)(lds + MTAB_OFF);
          EpiOut e{stat_ptr(c, ST_H), stat_ptr(c, ST_A), stat_ptr(c, ST_S), SW / 256, SW / 32, c.in[0], c.in[1], (const bf16*)xb, hb, mtab};
          for (int it = 0; it < 2; ++it) {
          if (STAG(it)) { GArgs g{mg, D, w.wout, D, D, MP, 4, D / 32, AW}; sq2_gemm(lds, g, e, G, bx, tid); continue; }
          pg8::Gemm gg{mg, w.wout, MP, D, D}; pg8::StaticOrder S; S.init(MP, D, G, bx);
          { int t2 = tid; asm volatile("" : "+v"(t2)); for (int i = 0; i < 2; ++i) { pg8::Unit u; if (S.next(i, u) && (t2 >> 8) == i) mtab[t2] = e.mid_scale(u.pm * 256 + (t2 & 255)); } }
          __syncthreads();
          pg8::gemm_phase<false>(lds, red, gg, S, e, tid); } }
        GRID_SYNC();
        for (int it = 0; it < 2; ++it) {
        if (STAG(it)) { PHASE_CTX EpiGU e{nullptr, stat_ptr(c, ST_H), D / 256, D / 32, act};
          GArgs g{hb, D, w.wgu, D, D, MP, 1, DFF / 32, 0}; sk_gemm<2, true>(lds, g, e, G, bx, tid);
          pg8::Gemm gg{hb, w.wgu, MP, NGU, D}; pg8::StaticOrder S; S.init(MP, NGU, G, bx); pg8::gemm_phase<true>(lds, red, gg, S, e, tid); }
        else { PHASE_CTX
          EpiPP e{nullptr, pp};
          GArgs g{pb, PLE, w.wpp, PLE, PLE, MP, 1, D / 32, 0}; sk_gemm<1, false>(lds, g, e, G, (bx + G - 176) % G, tid);
          pg8::Gemm gg{pb, w.wpp, MP, D, PLE}; pg8::StaticOrder S; S.init(MP, D, G, bx); pg8::gemm_phase<false>(lds, red, gg, S, e, tid); } }
        GRID_SYNC();
        { PHASE_CTX EpiDown e{stat_ptr(c, ST_H2), hb};
          for (int it = 0; it < 2; ++it) {
              if (STAG(it)) { GArgs g{act, DFF, w.wdown, DFF, DFF, MP, 4, D / 32, 0}; sq2_gemm(lds, g, e, G, bx, tid); }
              else { pg8::Gemm gg{act, w.wdown, MP, D, DFF}; pg8::StaticOrder S; S.init(MP, D, G, bx); pg8::gemm_phase<false>(lds, red, gg, S, e, tid); } } }
        GRID_SYNC();
        { PHASE_CTX EpiPle e{stat_ptr(c, ST_X), stat_ptr(c, ST_H2), D / 256, D / 32, pp, hb, xb, c.out + O_YP, c.out + O_YS, l == NL - 1 ? 1 : 0};
          for (int it = 0; it < 2; ++it) {
              if (STAG(it)) { GArgs g{hb, D, w.wple, D, D, MP, 4, D / 32, 0}; sq2_gemm(lds, g, e, G, bx, tid); }
              else { pg8::Gemm gg{hb, w.wple, MP, D, D}; pg8::StaticOrder S; S.init(MP, D, G, bx); pg8::gemm_phase<false>(lds, red, gg, S, e, tid); } } }
        if (l + 1 < NL) GRID_SYNC();
    }
}

extern "C" void kernel_launch(void* const* d_in, const int* in_sizes, int n_in, void* d_out, int out_size, void* d_ws, size_t ws_size, hipStream_t stream) {
    if (n_in != 34 || (size_t)out_size != O_END || ws_size < WS_END) { fprintf(stderr, "kernel_launch: unexpected sizes n_in %d out %d (want %zu) ws %zu (want %zu)\n", n_in, out_size, (size_t)O_END, ws_size, (size_t)WS_END); return; }
    static int grid = 0;
    if (grid == 0) {
        int dev = 0, cus = 0, per_cu = 0;
        if (hipGetDevice(&dev) != hipSuccess || hipDeviceGetAttribute(&cus, hipDeviceAttributeMultiprocessorCount, dev) != hipSuccess) { fprintf(stderr, "kernel_launch: device query failed\n"); grid = -1; return; }
        if (hipFuncSetAttribute((const void*)mega, hipFuncAttributeMaxDynamicSharedMemorySize, LDS_BYTES) != hipSuccess) { fprintf(stderr, "kernel_launch: hipFuncSetAttribute failed\n"); grid = -1; return; }
        if (hipOccupancyMaxActiveBlocksPerMultiprocessor(&per_cu, (const void*)mega, 512, LDS_BYTES) != hipSuccess || per_cu < 1) { fprintf(stderr, "kernel_launch: occupancy query says %d blocks per CU\n", per_cu); (void)hipGetLastError(); per_cu = 1; }
        grid = cus;
    }
    if (grid < 0) return;
    (void)hipMemsetAsync((char*)d_ws + WS_CTL, 0, CTL_BYTES, stream);
    Ctx c{}; for (int i = 0; i < 34; ++i) c.in[i] = (const float*)d_in[i]; c.out = (float*)d_out; c.ws = (unsigned char*)d_ws;
    hipLaunchKernelGGL(mega, dim3(grid), dim3(512), LDS_BYTES, stream, c);
}
```

```cpp
#include <hip/hip_runtime.h>
#include <cstdio>
#include <cstdint>

#define LAS __attribute__((address_space(3)))
#define GAS __attribute__((address_space(1)))
typedef unsigned short bf16;
typedef short bf16x8 __attribute__((ext_vector_type(8)));
typedef short s16x4 __attribute__((ext_vector_type(4)));
typedef float f32x4 __attribute__((ext_vector_type(4)));
typedef float f32x2 __attribute__((ext_vector_type(2)));
typedef float f32x16 __attribute__((ext_vector_type(16)));
typedef unsigned u32x4 __attribute__((ext_vector_type(4)));
typedef unsigned u32x2 __attribute__((ext_vector_type(2)));

constexpr int D = 2048, MP = 16384, MS = 256, MT = MP + MS, NH = 8, HD = 128, AW = 1024, SW = 1024, NG = 64, NP = 64, DFF = 5632, PLE = 256, INC = 4104;
constexpr int NL = 2, PAST = 2048, SEQ = 2048, DSEQ = 16, NBAT = 8, DBAT = 16, NGU = 2 * DFF;
constexpr float EPS = 1e-6f;
constexpr float QSCALE = 0.08838834764831845f * 1.4426950408889634f;
constexpr float LOG2E = 1.4426950408889634f;
constexpr int SS = 64;

constexpr size_t O_YP = 0, O_YS = O_YP + (size_t)MP * D, O_KP = O_YS + (size_t)MS * D, O_VP = O_KP + (size_t)NL * MP * AW, O_LFP = O_VP + (size_t)NL * MP * AW,
                 O_SRP = O_LFP + (size_t)NL * MP * NH, O_SIP = O_SRP + (size_t)NL * NBAT * NG * NP, O_KS = O_SIP + (size_t)NL * NBAT * NG * NP, O_VS = O_KS + (size_t)NL * MS * AW,
                 O_LFS = O_VS + (size_t)NL * MS * AW, O_SRS = O_LFS + (size_t)NL * MS * NH, O_SIS = O_SRS + (size_t)NL * DBAT * NG * NP, O_END = O_SIS + (size_t)NL * DBAT * NG * NP;

constexpr size_t al256(size_t x) { return (x + 255) & ~(size_t)255; }
constexpr size_t WS_CTL = 0, CTL_BYTES = 1 << 20;
constexpr size_t W_IN = 0, W_F = W_IN + (size_t)4096 * D * 2, W_GLU = W_F + (size_t)32 * D * 2, W_OUT = W_GLU + (size_t)SW * SW * 2, W_GU = W_OUT + (size_t)D * D * 2,
                 W_DOWN = W_GU + (size_t)NGU * D * 2, W_PLE = W_DOWN + (size_t)D * DFF * 2, W_PP = W_PLE + (size_t)D * D * 2, W_ABR = W_PP + (size_t)D * PLE * 2,
                 W_ABI = W_ABR + (size_t)NG * NP * 4, W_BCAT = W_ABI + (size_t)NG * NP * 4, W_CCAT = W_BCAT + (size_t)NG * 128 * 16 * 2, W_LAYER = al256(W_CCAT + (size_t)NG * 16 * 128 * 2);
constexpr size_t WS_W = CTL_BYTES;
constexpr size_t WS_XB = WS_W + NL * W_LAYER;
constexpr size_t WS_HF = WS_XB + (size_t)MT * D * 2;
constexpr size_t WS_HB = WS_HF + (size_t)MT * D * 4;
constexpr size_t WS_PB = WS_HB + (size_t)MT * D * 2;
constexpr size_t WS_PP = WS_PB + (size_t)NL * MT * PLE * 2;
constexpr size_t WS_ST = WS_PP + (size_t)MT * D * 2;
constexpr size_t ST_BYTES = (size_t)MT * SS * 4;
constexpr size_t WS_CUM = WS_ST + 5 * ST_BYTES;
constexpr size_t WS_OV = al256(WS_CUM + (size_t)MP * NH * 4 + (size_t)DBAT * (PAST + DSEQ) * NH * 4);
constexpr size_t WS_QB = WS_OV, WS_KB = WS_QB + (size_t)MT * AW * 2, WS_VB = WS_KB + (size_t)MT * AW * 2, WS_UB = WS_VB + (size_t)MT * AW * 2,
                 WS_GS = WS_UB + (size_t)MT * SW * 2, WS_MG = WS_GS + (size_t)MT * SW * 2, WS_OV_END1 = WS_MG + (size_t)MT * D * 2;
constexpr size_t WS_ACT = WS_OV, WS_OV_END2 = WS_ACT + (size_t)MT * DFF * 2;
constexpr size_t WS_END = WS_OV_END1 > WS_OV_END2 ? WS_OV_END1 : WS_OV_END2;

struct Ctx {
    const float* in[34];
    float* out;
    unsigned char* ws;
};

typedef __bf16 bf16x2_t __attribute__((ext_vector_type(2)));
__device__ __forceinline__ unsigned cvtpk(float lo, float hi) { const f32x2 v = {lo, hi}; const bf16x2_t b = __builtin_convertvector(v, bf16x2_t); return __builtin_bit_cast(unsigned, b); }
__device__ __forceinline__ float bf2f(unsigned short b) { return __uint_as_float(((unsigned)b) << 16); }
__device__ __forceinline__ float bflo(unsigned w) { return __uint_as_float(w << 16); }
__device__ __forceinline__ float bfhi(unsigned w) { return __uint_as_float(w & 0xffff0000u); }
__device__ __forceinline__ float wave_sum(float v) {
#pragma unroll
    for (int o = 1; o < 64; o <<= 1) v += __shfl_xor(v, o);
    return v;
}
__device__ __forceinline__ float wave_max(float v) {
#pragma unroll
    for (int o = 1; o < 64; o <<= 1) v = fmaxf(v, __shfl_xor(v, o));
    return v;
}
__device__ __forceinline__ float sigmoidf_(float x) { return __builtin_amdgcn_rcpf(1.0f + __builtin_amdgcn_exp2f(x * -1.4426950408889634f)); }
__device__ __forceinline__ float log_sigmoid_(float z) { return fminf(z, 0.f) - log1pf(expf(-fabsf(z))); }
__device__ __forceinline__ float gelu_tanh_(float y) { const float t = 0.7978845608028654f * (y + 0.044715f * y * y * y); return y * sigmoidf_(2.0f * t); }

struct Lw {
    const bf16 *win, *wf, *wglu, *wout, *wgu, *wdown, *wple, *wpp, *bcat, *ccat; const float *abr, *abi;
};
__device__ __forceinline__ Lw layer_w(const Ctx& c, int l) {
    unsigned char* b = c.ws + WS_W + (size_t)l * W_LAYER; Lw w;
    w.win = (const bf16*)(b + W_IN); w.wf = (const bf16*)(b + W_F); w.wglu = (const bf16*)(b + W_GLU); w.wout = (const bf16*)(b + W_OUT); w.wgu = (const bf16*)(b + W_GU);
    w.wdown = (const bf16*)(b + W_DOWN); w.wple = (const bf16*)(b + W_PLE); w.wpp = (const bf16*)(b + W_PP); w.abr = (const float*)(b + W_ABR); w.abi = (const float*)(b + W_ABI);
    w.bcat = (const bf16*)(b + W_BCAT); w.ccat = (const bf16*)(b + W_CCAT); return w;
}
__device__ __forceinline__ float* stat_ptr(const Ctx& c, int which) { return (float*)(c.ws + WS_ST + (size_t)which * ST_BYTES); }
enum { ST_X = 0, ST_A = 1, ST_S = 2, ST_H = 3, ST_H2 = 4 };
__device__ __forceinline__ float row_rs(const float* st, int row, int ns, float invn) {
    const float* p = st + (size_t)row * SS; float s = 0.f;
    if (ns == 1) s = p[0];
    else for (int i = 0; i < ns; i += 4) { const f32x4 v = *(const f32x4*)(p + i); s += (v.x + v.y) + (v.z + v.w); }
    return rsqrtf(s * invn + EPS);
}

struct TrItem { const float* W; int ldw, src_col0; const float* gain; bf16* WT; int K, dst_row0, k0, nvalid; };
__device__ __forceinline__ void tr_load(const TrItem& t, f32x4 (&v)[8], int lane) {
    const int kr = lane >> 3, n4 = (lane & 7) * 4;
#pragma unroll
    for (int i = 0; i < 8; ++i) v[i] = (n4 < t.nvalid) ? *(const f32x4*)(t.W + (size_t)(t.k0 + 8 * i + kr) * t.ldw + t.src_col0 + n4) : (f32x4){0.f, 0.f, 0.f, 0.f};
}
__device__ __forceinline__ void tr_store(const TrItem& t, const f32x4 (&v)[8], LAS float* scr, int lane) {
    const int kr = lane >> 3, n4 = (lane & 7) * 4;
#pragma unroll
    for (int i = 0; i < 8; ++i) { const int kk = 8 * i + kr; const float gn = t.gain ? t.gain[t.k0 + kk] : 1.0f; LAS float* d = scr + kk * 33 + n4;
        d[0] = v[i].x * gn; d[1] = v[i].y * gn; d[2] = v[i].z * gn; d[3] = v[i].w * gn; }
    asm volatile("s_waitcnt lgkmcnt(0)" ::: "memory");
    const int c = lane & 7;
#pragma unroll
    for (int j = 0; j < 4; ++j) { const int n = (lane >> 3) + 8 * j; const LAS float* s = scr + (8 * c) * 33 + n;
        u32x4 o; o.x = cvtpk(s[0 * 33], s[1 * 33]); o.y = cvtpk(s[2 * 33], s[3 * 33]); o.z = cvtpk(s[4 * 33], s[5 * 33]); o.w = cvtpk(s[6 * 33], s[7 * 33]);
        *(u32x4*)(t.WT + (size_t)(t.dst_row0 + n) * t.K + t.k0 + 8 * c) = o; }
    asm volatile("s_waitcnt lgkmcnt(0)" ::: "memory");
}
constexpr int I_IN = 32 * 128, I_GU = 32 * 352, I_OUT = 32 * 64, I_GLU = 16 * 32, I_DOWN = 88 * 64, I_PLE = 32 * 64, I_PP = 4 * 64, I_F = 32;
constexpr int I_LAYER = I_IN + I_GU + I_OUT + I_GLU + I_DOWN + I_PLE + I_PP + I_F;
__device__ __forceinline__ TrItem tr_item_of(const Ctx& c, int it) {
    const int l = it / I_LAYER; int r = it % I_LAYER; unsigned char* wb = c.ws + WS_W + (size_t)l * W_LAYER; TrItem t;
    if (r < I_IN) { const int kb = r / 128, nb = r % 128, n0 = 32 * nb;
        t = TrItem{c.in[10] + (size_t)l * D * INC, INC, n0 + (n0 >= 3072 ? 8 : 0), c.in[9] + l * D, (bf16*)(wb + W_IN), D, n0, 64 * kb, 32}; return t; } r -= I_IN;
    if (r < I_GU) { const int kb = r / 352, nb = r % 352, n0 = 32 * nb, pn = n0 >> 8, half = (n0 >> 7) & 1, j0 = n0 & 127;
        t = TrItem{(half ? c.in[29] : c.in[28]) + (size_t)l * D * DFF, DFF, 128 * pn + j0, c.in[27] + l * D, (bf16*)(wb + W_GU), D, n0, 64 * kb, 32}; return t; } r -= I_GU;
    if (r < I_OUT) { const int kb = r / 64, nb = r % 64, k0 = 64 * kb;
        t = TrItem{c.in[26] + (size_t)l * D * D, D, 32 * nb, (k0 < AW) ? (c.in[24] + l * AW) : (c.in[25] + l * SW - AW), (bf16*)(wb + W_OUT), D, 32 * nb, k0, 32}; return t; } r -= I_OUT;
    if (r < I_GLU) { const int kb = r / 32, nb = r % 32;
        t = TrItem{c.in[22] + (size_t)l * SW * SW, SW, 32 * nb, nullptr, (bf16*)(wb + W_GLU), SW, 32 * nb, 64 * kb, 32}; return t; } r -= I_GLU;
    if (r < I_DOWN) { const int kb = r / 64, nb = r % 64;
        t = TrItem{c.in[30] + (size_t)l * DFF * D, D, 32 * nb, nullptr, (bf16*)(wb + W_DOWN), DFF, 32 * nb, 64 * kb, 32}; return t; } r -= I_DOWN;
    if (r < I_PLE) { const int kb = r / 64, nb = r % 64;
        t = TrItem{c.in[32] + (size_t)l * D * D, D, 32 * nb, c.in[31] + l * D, (bf16*)(wb + W_PLE), D, 32 * nb, 64 * kb, 32}; return t; } r -= I_PLE;
    if (r < I_PP) { const int kb = r / 64, nb = r % 64;
        t = TrItem{c.in[33] + (size_t)l * PLE * D, D, 32 * nb, nullptr, (bf16*)(wb + W_PP), PLE, 32 * nb, 64 * kb, 32}; return t; } r -= I_PP;
    t = TrItem{c.in[10] + (size_t)l * D * INC, INC, 3072, c.in[9] + l * D, (bf16*)(wb + W_F), D, 0, 64 * r, 8}; return t;
}

__device__ __forceinline__ void p0_prologue(const Ctx& c, LAS unsigned char* lds, int gw, int ngw, int wave, int lane) {
    LAS float* scr = (LAS float*)(lds + wave * 8448);
    { f32x4 va[8], vb_[8]; int it = gw;
      TrItem ta = tr_item_of(c, it < NL * I_LAYER ? it : 0), tb = ta;
      if (it < NL * I_LAYER) tr_load(ta, va, lane);
      while (it < NL * I_LAYER) {
          const int i1 = it + ngw; if (i1 < NL * I_LAYER) { tb = tr_item_of(c, i1); tr_load(tb, vb_, lane); }
          tr_store(ta, va, scr, lane);
          if (i1 >= NL * I_LAYER) break;
          const int i2 = i1 + ngw; if (i2 < NL * I_LAYER) { ta = tr_item_of(c, i2); tr_load(ta, va, lane); }
          tr_store(tb, vb_, scr, lane);
          it = i2;
      } }
    for (int i = gw * 64 + lane; i < NL * NG * NP; i += ngw * 64) {
        const int l = i / (NG * NP), g = (i / NP) % NG, p = i % NP; unsigned char* wb = c.ws + WS_W + (size_t)l * W_LAYER;
        const float ar = c.in[14][i], ai = c.in[15][i], dt = expf(c.in[16][l * NG + g]);
        const float mag = expf(ar * dt), ang = ai * dt, abr = mag * cosf(ang), abi = mag * sinf(ang), den = ar * ar + ai * ai, nr = abr - 1.0f, ni = abi;
        const float cr = (nr * ar + ni * ai) / den, ci = (ni * ar - nr * ai) / den;
        ((float*)(wb + W_ABR))[g * NP + p] = abr; ((float*)(wb + W_ABI))[g * NP + p] = abi;
        const float* br = c.in[17] + (size_t)i * 16; const float* bi = c.in[18] + (size_t)i * 16;
        bf16* bc = (bf16*)(wb + W_BCAT) + (size_t)g * 128 * 16;
        for (int ch = 0; ch < 16; ch += 2) {
            const float r0 = cr * br[ch] - ci * bi[ch], r1 = cr * br[ch + 1] - ci * bi[ch + 1], i0 = cr * bi[ch] + ci * br[ch], i1 = cr * bi[ch + 1] + ci * br[ch + 1];
            *(unsigned*)(bc + p * 16 + ch) = cvtpk(r0, r1); *(unsigned*)(bc + (64 + p) * 16 + ch) = cvtpk(i0, i1); }
        bf16* cc = (bf16*)(wb + W_CCAT) + (size_t)g * 16 * 128;
        const float* cre = c.in[19] + ((size_t)l * NG + g) * 16 * NP; const float* cim = c.in[20] + ((size_t)l * NG + g) * 16 * NP;
        for (int ch = 0; ch < 16; ++ch) { cc[ch * 128 + p] = (bf16)(cvtpk(cre[ch * NP + p], 0.f) & 0xffff); cc[ch * 128 + 64 + p] = (bf16)(cvtpk(-cim[ch * NP + p], 0.f) & 0xffff); }
    }
    bf16* xb = (bf16*)(c.ws + WS_XB); float* stx = stat_ptr(c, ST_X);
    for (int row0 = 2 * gw; row0 < MT; row0 += 2 * ngw) {
        f32x4 v[2][8];
#pragma unroll
        for (int q = 0; q < 2; ++q) { const int row = row0 + q; const float* xr = row < MP ? c.in[0] + (size_t)row * D : c.in[1] + (size_t)(row - MP) * D;
#pragma unroll
            for (int j = 0; j < 8; ++j) v[q][j] = *(const f32x4*)(xr + j * 256 + lane * 4); }
#pragma unroll
        for (int q = 0; q < 2; ++q) { const int row = row0 + q; float s = 0.f;
#pragma unroll
            for (int j = 0; j < 8; ++j) { const f32x4 w = v[q][j]; s += (w.x * w.x + w.y * w.y) + (w.z * w.z + w.w * w.w);
                u32x2 o; o.x = cvtpk(w.x, w.y); o.y = cvtpk(w.z, w.w); *(u32x2*)(xb + (size_t)row * D + j * 256 + lane * 4) = o; }
            s = wave_sum(s); if (lane == 0) stx[(size_t)row * SS] = s; }
    }
    bf16* pb = (bf16*)(c.ws + WS_PB);
    for (int i0 = 8 * gw; i0 < NL * MT; i0 += 8 * ngw) {
        f32x4 v[8];
#pragma unroll
        for (int q = 0; q < 8; ++q) { const int i = i0 + q, l = i / MT, row = i % MT;
            const float* pr = row < MP ? c.in[7] + ((size_t)l * MP + row) * PLE : c.in[8] + ((size_t)l * MS + (row - MP)) * PLE; v[q] = *(const f32x4*)(pr + lane * 4); }
#pragma unroll
        for (int q = 0; q < 8; ++q) { u32x2 o; o.x = cvtpk(v[q].x, v[q].y); o.y = cvtpk(v[q].z, v[q].w); *(u32x2*)(pb + (size_t)(i0 + q) * PLE + lane * 4) = o; } }
}

constexpr size_t UB_S_OFF = (size_t)NBAT * NG * SEQ * 16;
__device__ __forceinline__ void st_bf4(bf16* p, f32x4 v) { u32x2 o; o.x = cvtpk(v.x, v.y); o.y = cvtpk(v.z, v.w); *(u32x2*)p = o; }
__device__ __forceinline__ f32x4 ld_bf4(const bf16* p) { const u32x2 w = *(const u32x2*)p; return (f32x4){bflo(w.x), bfhi(w.x), bflo(w.y), bfhi(w.y)}; }
__device__ __forceinline__ float sumsq4(f32x4 v) { return (v.x * v.x + v.y * v.y) + (v.z * v.z + v.w * v.w); }

struct EpiIn {
    static constexpr bool MID = false, STATS = false, HAS_RS = true, QKN = true;
    const float* stx; int nsP, nsS; float* st;
    bf16 *qb, *vb, *ub; float *kP, *kS, *vP, *vS; bf16* kb; const float *gq, *gk;
    __device__ __forceinline__ float row_begin(int row) const { return row_rs(stx, row, row < MP ? nsP : nsS, 1.0f / D); }
    __device__ __forceinline__ float mid_scale(int) const { return 1.f; }
    __device__ __forceinline__ float apply(float rs, int row, int col, f32x4 v) const {
        v = v * rs;
        if (col < 1024) { st_bf4(qb + (size_t)row * AW + col, v); }
        else if (col < 2048) { float* k = row < MP ? kP + (size_t)row * AW : kS + (size_t)(row - MP) * AW; *(f32x4*)(k + (col - 1024)) = v; }
        else if (col < 3072) { float* vo = row < MP ? vP + (size_t)row * AW : vS + (size_t)(row - MP) * AW; *(f32x4*)(vo + (col - 2048)) = v; st_bf4(vb + (size_t)row * AW + (col - 2048), v); }
        else { const int c = col - 3072, g = c >> 4, ch = c & 15; const int r = row - MP;
            const size_t idx = row < MP ? (((size_t)(row >> 11) * NG + g) * SEQ + (row & 2047)) * 16 + ch : UB_S_OFF + (((size_t)(r >> 4) * NG + g) * DSEQ + (r & 15)) * 16 + ch;
            st_bf4(ub + idx, v); }
        return 0.f;
    }
};
struct EpiF {
    static constexpr bool MID = false, STATS = false, HAS_RS = true, QKN = false;
    const float* stx; int nsP, nsS; float* st;
    const float* bf; float *lfP, *lfS;
    __device__ __forceinline__ float row_begin(int row) const { return row_rs(stx, row, row < MP ? nsP : nsS, 1.0f / D); }
    __device__ __forceinline__ float mid_scale(int) const { return 1.f; }
    __device__ __forceinline__ float apply(float rs, int row, int col, f32x4 v) const {
        if (col < 8) { f32x4 o;
#pragma unroll
            for (int e = 0; e < 4; ++e) o[e] = log_sigmoid_(rs * v[e] + bf[col + e]);
            float* p = row < MP ? lfP + (size_t)row * NH : lfS + (size_t)(row - MP) * NH; *(f32x4*)(p + col) = o; }
        return 0.f;
    }
};
struct EpiGlu {
    static constexpr bool MID = false, STATS = true, HAS_RS = false, QKN = false;
    float* st; const float* bglu; const bf16* gs; bf16* mg;
    __device__ __forceinline__ float row_begin(int) const { return 1.f; }
    __device__ __forceinline__ float mid_scale(int) const { return 1.f; }
    __device__ __forceinline__ float apply(float, int row, int col, f32x4 v) const {
        const f32x4 b = *(const f32x4*)(bglu + col); const f32x4 g = ld_bf4(gs + (size_t)row * SW + col); f32x4 s;
#pragma unroll
        for (int e = 0; e < 4; ++e) s[e] = g[e] * sigmoidf_(v[e] + b[e]);
        st_bf4(mg + (size_t)row * D + AW + col, s); return sumsq4(s);
    }
};
struct EpiOut {
    static constexpr bool MID = true, STATS = true, HAS_RS = true, QKN = false;
    float* st; const float *sta, *sts; int nsS_P, nsS_S; const float *xinP, *xinS; const bf16* xinB; bf16* hb; const LAS float* mid_tab;
    __device__ __forceinline__ float r_s(int row) const { return row_rs(sts, row, row < MP ? nsS_P : nsS_S, 1.0f / SW); }
    __device__ __forceinline__ float row_begin(int row) const { return r_s(row); }
    __device__ __forceinline__ float mid_scale(int row) const { return row_rs(sta, row, NH, 1.0f / AW) / r_s(row); }
    __device__ __forceinline__ float apply(float rs, int row, int col, f32x4 v) const {
        f32x4 x;
        if (xinB) x = ld_bf4(xinB + (size_t)row * D + col); else { const float* xin = row < MP ? xinP + (size_t)row * D : xinS + (size_t)(row - MP) * D; x = *(const f32x4*)(xin + col); }
        const f32x4 h = x + v * rs;
        st_bf4(hb + (size_t)row * D + col, h); return sumsq4(h);
    }
};
struct EpiGU {
    static constexpr bool MID = false, STATS = false, HAS_RS = true, QKN = false;
    float* st; const float* sth; int nsP, nsS; bf16* act;
    __device__ __forceinline__ float row_begin(int row) const { return row_rs(sth, row, row < MP ? nsP : nsS, 1.0f / D); }
    __device__ __forceinline__ float mid_scale(int) const { return 1.f; }
    __device__ __forceinline__ float apply2(float rs, int row, int col, f32x4 vg, f32x4 vu) const {
        f32x4 a;
#pragma unroll
        for (int e = 0; e < 4; ++e) { const float g = rs * vg[e], u = rs * vu[e]; a[e] = g * sigmoidf_(g) * u; }
        st_bf4(act + (size_t)row * DFF + col, a); return 0.f;
    }
};
struct EpiDown {
    static constexpr bool MID = false, STATS = true, HAS_RS = false, QKN = false;
    float* st; bf16* hb;
    __device__ __forceinline__ float row_begin(int) const { return 1.f; }
    __device__ __forceinline__ float mid_scale(int) const { return 1.f; }
    __device__ __forceinline__ float apply(float, int row, int col, f32x4 v) const {
        bf16* p = hb + (size_t)row * D + col; const f32x4 h = ld_bf4(p) + v; st_bf4(p, h); return sumsq4(h);
    }
};
struct EpiPP {
    static constexpr bool MID = false, STATS = false, HAS_RS = false, QKN = false;
    float* st; bf16* pp;
    __device__ __forceinline__ float row_begin(int) const { return 1.f; }
    __device__ __forceinline__ float mid_scale(int) const { return 1.f; }
    __device__ __forceinline__ float apply(float, int row, int col, f32x4 v) const { st_bf4(pp + (size_t)row * D + col, v); return 0.f; }
};
struct EpiPle {
    static constexpr bool MID = false, STATS = true, HAS_RS = true, QKN = false;
    float* st; const float* sth2; int nsP, nsS; const bf16* pp; const bf16* hb; bf16* xb; float *yP, *yS; int last;
    __device__ __forceinline__ float row_begin(int row) const { return row_rs(sth2, row, row < MP ? nsP : nsS, 1.0f / D); }
    __device__ __forceinline__ float mid_scale(int) const { return 1.f; }
    __device__ __forceinline__ float apply(float rs, int row, int col, f32x4 v) const {
        const f32x4 h = ld_bf4(hb + (size_t)row * D + col); const f32x4 q = ld_bf4(pp + (size_t)row * D + col); f32x4 o;
#pragma unroll
        for (int e = 0; e < 4; ++e) o[e] = h[e] + sigmoidf_(rs * v[e]) * q[e];
        if (last) { float* y = row < MP ? yP + (size_t)row * D : yS + (size_t)(row - MP) * D; *(f32x4*)(y + col) = o; return 0.f; }
        st_bf4(xb + (size_t)row * D + col, o); return sumsq4(o);
    }
};

struct GArgs { const bf16* A; int lda; const bf16* Bt; int ldb; int K; int r0; int nrt; int nct; int kmid; };
template <int NB, bool PAIR, class F>
__device__ __forceinline__ void dg_gemm(const GArgs& g, const F& f, int gw, int ngw, int lane) {
    asm volatile("" : "+v"(lane));
    const int r32 = lane & 31, h = lane >> 5, ntiles = g.nrt * g.nct, nks = g.K / 16;
    for (int t = gw; t < ntiles; t += ngw) {
        const int tr = t / g.nct, tc = t % g.nct, row = g.r0 + 32 * tr + r32;
        int nb0, nb1, colbase;
        if (PAIR) { nb0 = 256 * (tc >> 2) + 32 * (tc & 3); nb1 = nb0 + 128; colbase = 32 * tc; } else { nb0 = 32 * NB * tc; nb1 = nb0 + 32; colbase = nb0; }
        const bf16* ap = g.A + (size_t)row * g.lda + 8 * h;
        const bf16* bp0 = g.Bt + (size_t)(nb0 + r32) * g.ldb + 8 * h;
        const bf16* bp1 = g.Bt + (size_t)(nb1 + r32) * g.ldb + 8 * h;
        f32x16 acc0 = {}, acc1 = {};
        const int k1 = F::MID ? g.kmid / 16 : nks;
#pragma unroll 4
        for (int ks = 0; ks < k1; ++ks) {
            const bf16x8 a = *(const bf16x8*)(ap + 16 * ks); const bf16x8 b0 = *(const bf16x8*)(bp0 + 16 * ks);
            acc0 = __builtin_amdgcn_mfma_f32_32x32x16_bf16(b0, a, acc0, 0, 0, 0);
            if (NB == 2) { const bf16x8 b1 = *(const bf16x8*)(bp1 + 16 * ks); acc1 = __builtin_amdgcn_mfma_f32_32x32x16_bf16(b1, a, acc1, 0, 0, 0); }
        }
        if (F::MID) {
            const float sc = f.mid_scale(row);
#pragma unroll
            for (int i = 0; i < 16; ++i) { acc0[i] *= sc; acc1[i] *= sc; }
#pragma unroll 4
            for (int ks = k1; ks < nks; ++ks) {
                const bf16x8 a = *(const bf16x8*)(ap + 16 * ks); const bf16x8 b0 = *(const bf16x8*)(bp0 + 16 * ks);
                acc0 = __builtin_amdgcn_mfma_f32_32x32x16_bf16(b0, a, acc0, 0, 0, 0);
                if (NB == 2) { const bf16x8 b1 = *(const bf16x8*)(bp1 + 16 * ks); acc1 = __builtin_amdgcn_mfma_f32_32x32x16_bf16(b1, a, acc1, 0, 0, 0); }
            }
        }
        const float rs = f.row_begin(row); float ss = 0.f;
        if constexpr (PAIR) {
#pragma unroll
            for (int gq = 0; gq < 4; ++gq) ss += f.apply2(rs, row, colbase + 8 * gq + 4 * h, (f32x4){acc0[4 * gq], acc0[4 * gq + 1], acc0[4 * gq + 2], acc0[4 * gq + 3]}, (f32x4){acc1[4 * gq], acc1[4 * gq + 1], acc1[4 * gq + 2], acc1[4 * gq + 3]});
        } else {
#pragma unroll
            for (int gq = 0; gq < 4; ++gq) ss += f.apply(rs, row, colbase + 8 * gq + 4 * h, (f32x4){acc0[4 * gq], acc0[4 * gq + 1], acc0[4 * gq + 2], acc0[4 * gq + 3]});
            if (NB == 2) {
#pragma unroll
                for (int gq = 0; gq < 4; ++gq) ss += f.apply(rs, row, colbase + 32 + 8 * gq + 4 * h, (f32x4){acc1[4 * gq], acc1[4 * gq + 1], acc1[4 * gq + 2], acc1[4 * gq + 3]});
            }
        }
        if (F::STATS) { ss += __shfl_xor(ss, 32); if (h == 0) f.st[(size_t)row * SS + tc] = ss; }
    }
}

__device__ __forceinline__ float log_sigmoid_fast(float z) { return fminf(z, 0.f) - 0.6931471805599453f * __builtin_amdgcn_logf(1.0f + __builtin_amdgcn_exp2f(fabsf(z) * -1.4426950408889634f)); }
__device__ __forceinline__ void flogit_rows(const Ctx& c, int l, int gw, int ngw, int lane, int nsS) {
    asm volatile("" : "+v"(lane));
    const bf16* xb = (const bf16*)(c.ws + WS_XB); const Lw w = layer_w(c, l);
    for (int row = MP + gw; row < MT; row += ngw) {
        const bf16* xp = xb + (size_t)row * D + 8 * lane; const bf16* wp = w.wf + 8 * lane;
        float a0 = 0.f, a1 = 0.f, a2 = 0.f, a3 = 0.f, a4 = 0.f, a5 = 0.f, a6 = 0.f, a7 = 0.f;
#pragma unroll
        for (int j = 0; j < 4; ++j) {
            const u32x4 xv = *(const u32x4*)(xp + 512 * j);
            const float x0 = bflo(xv.x), x1 = bfhi(xv.x), x2 = bflo(xv.y), x3 = bfhi(xv.y), x4 = bflo(xv.z), x5 = bfhi(xv.z), x6 = bflo(xv.w), x7 = bfhi(xv.w);
#define FL_DOT(a, h) { const u32x4 wv = *(const u32x4*)(wp + (size_t)(h) * D + 512 * j); \
            a += (x0 * bflo(wv.x) + x1 * bfhi(wv.x)) + (x2 * bflo(wv.y) + x3 * bfhi(wv.y)) + (x4 * bflo(wv.z) + x5 * bfhi(wv.z)) + (x6 * bflo(wv.w) + x7 * bfhi(wv.w)); }
            FL_DOT(a0, 0) FL_DOT(a1, 1) FL_DOT(a2, 2) FL_DOT(a3, 3) FL_DOT(a4, 4) FL_DOT(a5, 5) FL_DOT(a6, 6) FL_DOT(a7, 7)
#undef FL_DOT
        }
#define FL_RED(a) { a += __shfl_xor(a, 32); a += __shfl_xor(a, 16); a += __shfl_xor(a, 8); a += __shfl_xor(a, 4); a += __shfl_xor(a, 2); a += __shfl_xor(a, 1); }
        FL_RED(a0) FL_RED(a1) FL_RED(a2) FL_RED(a3) FL_RED(a4) FL_RED(a5) FL_RED(a6) FL_RED(a7)
#undef FL_RED
        float v = a0; v = lane == 1 ? a1 : v; v = lane == 2 ? a2 : v; v = lane == 3 ? a3 : v; v = lane == 4 ? a4 : v; v = lane == 5 ? a5 : v; v = lane == 6 ? a6 : v; v = lane == 7 ? a7 : v;
        const float rs = row_rs(stat_ptr(c, ST_X), row, nsS, 1.0f / D);
        if (lane < NH) c.out[O_LFS + ((size_t)l * MS + (row - MP)) * NH + lane] = log_sigmoid_fast(rs * v + c.in[11][l * NH + lane]);
    }
}

__device__ __forceinline__ void qknorm_rows(const Ctx& c, int l, int gw, int ngw, int lane) {
    asm volatile("" : "+v"(lane));
    bf16* qb = (bf16*)(c.ws + WS_QB); bf16* kb = (bf16*)(c.ws + WS_KB);
    float* kP = c.out + O_KP + (size_t)l * MP * AW; float* kS = c.out + O_KS + (size_t)l * MS * AW;
    const float* gq = c.in[12] + l * HD; const float* gk = c.in[13] + l * HD; const int d0 = (16 * lane) & 127;
    for (int row = MP + gw; row < MT; row += ngw) {
        bf16* qp = qb + (size_t)row * AW + 16 * lane; float q[16];
        { const u32x4 w0 = *(const u32x4*)qp, w1 = *(const u32x4*)(qp + 8);
          q[0] = bflo(w0.x); q[1] = bfhi(w0.x); q[2] = bflo(w0.y); q[3] = bfhi(w0.y); q[4] = bflo(w0.z); q[5] = bfhi(w0.z); q[6] = bflo(w0.w); q[7] = bfhi(w0.w);
          q[8] = bflo(w1.x); q[9] = bfhi(w1.x); q[10] = bflo(w1.y); q[11] = bfhi(w1.y); q[12] = bflo(w1.z); q[13] = bfhi(w1.z); q[14] = bflo(w1.w); q[15] = bfhi(w1.w); }
        float ss = 0.f;
#pragma unroll
        for (int e = 0; e < 16; ++e) ss += q[e] * q[e];
        ss += __shfl_xor(ss, 1); ss += __shfl_xor(ss, 2); ss += __shfl_xor(ss, 4);
        float sc = rsqrtf(ss * (1.0f / HD) + EPS) * QSCALE;
#pragma unroll
        for (int e = 0; e < 16; ++e) q[e] *= sc * gq[d0 + e];
        { u32x4 o0, o1; o0.x = cvtpk(q[0], q[1]); o0.y = cvtpk(q[2], q[3]); o0.z = cvtpk(q[4], q[5]); o0.w = cvtpk(q[6], q[7]); o1.x = cvtpk(q[8], q[9]); o1.y = cvtpk(q[10], q[11]); o1.z = cvtpk(q[12], q[13]); o1.w = cvtpk(q[14], q[15]);
          *(u32x4*)qp = o0; *(u32x4*)(qp + 8) = o1; }
        float* kp = (row < MP ? kP + (size_t)row * AW : kS + (size_t)(row - MP) * AW) + 16 * lane; float k[16];
#pragma unroll
        for (int j = 0; j < 4; ++j) { const f32x4 v = *(const f32x4*)(kp + 4 * j); k[4 * j] = v.x; k[4 * j + 1] = v.y; k[4 * j + 2] = v.z; k[4 * j + 3] = v.w; }
        ss = 0.f;
#pragma unroll
        for (int e = 0; e < 16; ++e) ss += k[e] * k[e];
        ss += __shfl_xor(ss, 1); ss += __shfl_xor(ss, 2); ss += __shfl_xor(ss, 4);
        sc = rsqrtf(ss * (1.0f / HD) + EPS);
#pragma unroll
        for (int e = 0; e < 16; ++e) k[e] *= sc * gk[d0 + e];
#pragma unroll
        for (int j = 0; j < 4; ++j) *(f32x4*)(kp + 4 * j) = (f32x4){k[4 * j], k[4 * j + 1], k[4 * j + 2], k[4 * j + 3]};
        { bf16* kbp = kb + (size_t)row * AW + 16 * lane; u32x4 o0, o1; o0.x = cvtpk(k[0], k[1]); o0.y = cvtpk(k[2], k[3]); o0.z = cvtpk(k[4], k[5]); o0.w = cvtpk(k[6], k[7]); o1.x = cvtpk(k[8], k[9]); o1.y = cvtpk(k[10], k[11]); o1.z = cvtpk(k[12], k[13]); o1.w = cvtpk(k[14], k[15]);
          *(u32x4*)kbp = o0; *(u32x4*)(kbp + 8) = o1; }
    }
}

__device__ __forceinline__ void cumsum_simple(const Ctx& c, int l, int gw, int ngw, int lane) {
    asm volatile("" : "+v"(lane));
    float* cumP = (float*)(c.ws + WS_CUM); float* cumS = cumP + (size_t)MP * NH;
    const float* lfP = c.out + O_LFP + (size_t)l * MP * NH; const float* lfS = c.out + O_LFS + (size_t)l * MS * NH; const float* cl = c.in[4] + (size_t)l * DBAT * PAST * NH;
    for (int it = gw; it < NBAT * NH + DBAT * NH; it += ngw) {
        const bool smp = it >= NBAT * NH; const int i2 = smp ? it - NBAT * NH : it, b = i2 >> 3, h = i2 & 7, n = smp ? PAST + DSEQ : SEQ, per = (n + 63) / 64;
        float loc = 0.f;
        for (int j = 0; j < per; ++j) { const int t = lane * per + j; if (t < n) loc += smp ? (t < PAST ? cl[((size_t)b * PAST + t) * NH + h] : lfS[((size_t)b * DSEQ + (t - PAST)) * NH + h]) : lfP[((size_t)b * SEQ + t) * NH + h]; }
        float inc = loc;
#pragma unroll
        for (int o = 1; o < 64; o <<= 1) { const float v = __shfl_up(inc, o); if (lane >= o) inc += v; }
        float run = inc - loc;
        for (int j = 0; j < per; ++j) { const int t = lane * per + j; if (t < n) {
            run += smp ? (t < PAST ? cl[((size_t)b * PAST + t) * NH + h] : lfS[((size_t)b * DSEQ + (t - PAST)) * NH + h]) : lfP[((size_t)b * SEQ + t) * NH + h];
            if (smp) cumS[((size_t)b * (PAST + DSEQ) + t) * NH + h] = run * LOG2E; else cumP[((size_t)b * SEQ + t) * NH + h] = run * LOG2E; } }
    }
}
__device__ __forceinline__ void attn_simple(const Ctx& c, int l, int gw, int ngw, int lane, int row_lo = 0, int row_hi = MT) {
    asm volatile("" : "+v"(lane));
    const bf16* qb = (const bf16*)(c.ws + WS_QB); const bf16* kb = (const bf16*)(c.ws + WS_KB); const bf16* vb = (const bf16*)(c.ws + WS_VB); bf16* mg = (bf16*)(c.ws + WS_MG);
    const float* cumP = (const float*)(c.ws + WS_CUM); const float* cumS = cumP + (size_t)MP * NH; float* sta = stat_ptr(c, ST_A);
    const float* ck_ = c.in[2] + (size_t)l * DBAT * PAST * AW; const float* cv_ = c.in[3] + (size_t)l * DBAT * PAST * AW;
    for (int it = row_lo * NH + gw; it < row_hi * NH; it += ngw) {
        const int row = it >> 3, h = it & 7; const bool smp = row >= MP; const int r = row - MP;
        const int b = smp ? r >> 4 : row >> 11, pos = smp ? PAST + (r & 15) : row & 2047, nkeys = pos + 1;
        unsigned qv[64];
#pragma unroll
        for (int j = 0; j < 16; ++j) { const u32x4 w = *(const u32x4*)(qb + (size_t)row * AW + h * HD + 8 * j); qv[4 * j] = w.x; qv[4 * j + 1] = w.y; qv[4 * j + 2] = w.z; qv[4 * j + 3] = w.w; }
        const float cq = smp ? cumS[((size_t)b * (PAST + DSEQ) + pos) * NH + h] : cumP[(size_t)row * NH + h];
        float m = -1e30f, lsum = 0.f, o0 = 0.f, o1 = 0.f;
        for (int k0 = 0; k0 < nkeys; k0 += 64) {
            const int j = k0 + lane; const bool valid = j < nkeys; float s = 0.f;
            if (valid) {
                if (smp && j < PAST) { const float* kp = ck_ + ((size_t)b * PAST + j) * AW + h * HD;
#pragma unroll
                    for (int d = 0; d < 32; ++d) { const f32x4 kv = *(const f32x4*)(kp + 4 * d); s += bflo(qv[2 * d]) * kv.x + bfhi(qv[2 * d]) * kv.y + bflo(qv[2 * d + 1]) * kv.z + bfhi(qv[2 * d + 1]) * kv.w; }
                } else { const int kr = smp ? MP + b * DSEQ + (j - PAST) : (b << 11) + j; const bf16* kp = kb + (size_t)kr * AW + h * HD;
#pragma unroll
                    for (int d = 0; d < 16; ++d) { const u32x4 w = *(const u32x4*)(kp + 8 * d);
                        s += bflo(qv[4 * d]) * bflo(w.x) + bfhi(qv[4 * d]) * bfhi(w.x) + bflo(qv[4 * d + 1]) * bflo(w.y) + bfhi(qv[4 * d + 1]) * bfhi(w.y)
                           + bflo(qv[4 * d + 2]) * bflo(w.z) + bfhi(qv[4 * d + 2]) * bfhi(w.z) + bflo(qv[4 * d + 3]) * bflo(w.w) + bfhi(qv[4 * d + 3]) * bfhi(w.w); } }
                const float ck = smp ? cumS[((size_t)b * (PAST + DSEQ) + j) * NH + h] : cumP[((size_t)(b << 11) + j) * NH + h];
                s += cq - ck;
            } else s = -__builtin_inff();
            const float mn = fmaxf(m, wave_max(s)), alpha = __builtin_amdgcn_exp2f(m - mn), p = __builtin_amdgcn_exp2f(s - mn);
            lsum = lsum * alpha + wave_sum(p); o0 *= alpha; o1 *= alpha; m = mn;
            const int cnt = (nkeys - k0) < 64 ? (nkeys - k0) : 64;
            for (int jj = 0; jj < cnt; ++jj) { const float pj = __shfl(p, jj); const int jk = k0 + jj; float v0, v1;
                if (smp && jk < PAST) { const f32x2 vv = *(const f32x2*)(cv_ + ((size_t)b * PAST + jk) * AW + h * HD + 2 * lane); v0 = vv.x; v1 = vv.y; }
                else { const int kr = smp ? MP + b * DSEQ + (jk - PAST) : (b << 11) + jk; const unsigned w = *(const unsigned*)(vb + (size_t)kr * AW + h * HD + 2 * lane); v0 = bflo(w); v1 = bfhi(w); }
                o0 += pj * v0; o1 += pj * v1; }
        }
        const float inv = 1.0f / lsum; o0 *= inv; o1 *= inv;
        *(unsigned*)(mg + (size_t)row * D + h * HD + 2 * lane) = cvtpk(o0, o1);
        const float ss = wave_sum(o0 * o0 + o1 * o1); if (lane == 0) sta[(size_t)row * SS + h] = ss;
    }
}
__device__ __forceinline__ void ssm_simple(const Ctx& c, int l, int gw, int ngw, int lane) {
    asm volatile("" : "+v"(lane));
    const Lw w = layer_w(c, l); const bf16* ub = (const bf16*)(c.ws + WS_UB); bf16* gs = (bf16*)(c.ws + WS_GS);
    for (int it = gw; it < NBAT * NG + DBAT * NG; it += ngw) {
        const bool smp = it >= NBAT * NG; const int i2 = smp ? it - NBAT * NG : it, b = i2 / NG, g = i2 % NG, T = smp ? DSEQ : SEQ;
        const bf16* u = ub + (smp ? UB_S_OFF + (size_t)(b * NG + g) * DSEQ * 16 : (size_t)(b * NG + g) * SEQ * 16);
        const float abr = w.abr[g * NP + lane], abi = w.abi[g * NP + lane];
        float Br[16], Bi[16], Cr[16], Ci[16];
#pragma unroll
        for (int ch = 0; ch < 16; ++ch) { Br[ch] = bf2f(w.bcat[((size_t)g * 128 + lane) * 16 + ch]); Bi[ch] = bf2f(w.bcat[((size_t)g * 128 + 64 + lane) * 16 + ch]);
            Cr[ch] = bf2f(w.ccat[((size_t)g * 16 + ch) * 128 + lane]); Ci[ch] = bf2f(w.ccat[((size_t)g * 16 + ch) * 128 + 64 + lane]); }
        const float dsk = c.in[21][l * SW + g * 16 + (lane & 15)];
        float xr = 0.f, xi = 0.f;
        if (smp) { xr = c.in[5][(((size_t)l * DBAT + b) * NG + g) * NP + lane]; xi = c.in[6][(((size_t)l * DBAT + b) * NG + g) * NP + lane]; }
        for (int t = 0; t < T; ++t) {
            const u32x4 w0 = *(const u32x4*)(u + t * 16), w1 = *(const u32x4*)(u + t * 16 + 8);
            const float uu[16] = {bflo(w0.x), bfhi(w0.x), bflo(w0.y), bfhi(w0.y), bflo(w0.z), bfhi(w0.z), bflo(w0.w), bfhi(w0.w), bflo(w1.x), bfhi(w1.x), bflo(w1.y), bfhi(w1.y), bflo(w1.z), bfhi(w1.z), bflo(w1.w), bfhi(w1.w)};
            float bur = 0.f, bui = 0.f;
#pragma unroll
            for (int ch = 0; ch < 16; ++ch) { bur += Br[ch] * uu[ch]; bui += Bi[ch] * uu[ch]; }
            const float nxr = abr * xr - abi * xi + bur, nxi = abr * xi + abi * xr + bui; xr = nxr; xi = nxi;
            float yl = 0.f;
#pragma unroll
            for (int ch = 0; ch < 16; ++ch) { const float y = wave_sum(Cr[ch] * xr + Ci[ch] * xi); if (lane == ch) yl = y; }
            if (lane < 16) { const float y = yl + dsk * bf2f(u[t * 16 + lane]); const int row = smp ? MP + b * DSEQ + t : b * SEQ + t;
                gs[(size_t)row * SW + g * 16 + lane] = (bf16)(cvtpk(gelu_tanh_(y), 0.f) & 0xffff); }
        }
        float* sre = smp ? c.out + O_SRS + (((size_t)l * DBAT + b) * NG + g) * NP : c.out + O_SRP + (((size_t)l * NBAT + b) * NG + g) * NP;
        float* sim = smp ? c.out + O_SIS + (((size_t)l * DBAT + b) * NG + g) * NP : c.out + O_SIP + (((size_t)l * NBAT + b) * NG + g) * NP;
        sre[lane] = xr; sim[lane] = xi;
    }
}

#define XB_TMO      128
#define XB_XCNT(j)  (256  + 64 * (j))
#define XB_XSUB(j)  (1280 + 64 * (j))
#define XB_XGEN(j)  (2304 + 64 * (j))
#define XB_TOP      3328
#define XB_TOPGEN   3392
#define XCD_BAR_WORDS 3456
#define XB_SPIN_CAP (1u << 24)

__device__ __forceinline__ unsigned xb_ld(unsigned* p)              { return __hip_atomic_load(p, __ATOMIC_RELAXED, __HIP_MEMORY_SCOPE_AGENT); }
__device__ __forceinline__ unsigned xb_add(unsigned* p, unsigned v) { return __hip_atomic_fetch_add(p, v, __ATOMIC_RELAXED, __HIP_MEMORY_SCOPE_AGENT); }
__device__ __forceinline__ unsigned xb_xcc_id() { return (unsigned)__builtin_amdgcn_s_getreg((3 << 11) | 20) & 0xFu; }
#define XB_SPIN(cond, bar) do { unsigned _sp = 0; while (cond) { __builtin_amdgcn_s_sleep(1); \
    if ((++_sp & 255u) == 0u) { if (xb_ld(&(bar)[XB_TMO])) break; if (_sp > XB_SPIN_CAP) { atomicAdd(&(bar)[XB_TMO], 1u); break; } } } } while (0)

struct XcdBarrier {
    unsigned* bar; unsigned x;
    volatile LAS unsigned* st;
};

__device__ __forceinline__ XcdBarrier xcd_barrier_post(unsigned* bar, volatile LAS unsigned* st) {
    XcdBarrier b; b.bar = bar; b.x = xb_xcc_id(); b.st = st;
    if (threadIdx.x == 0) (void)xb_add(&bar[XB_XCNT(b.x)], 1u);
    return b;
}
__device__ __forceinline__ void xcd_barrier_complete(unsigned* bar, unsigned x, unsigned& nloc, unsigned& nx) {
    const unsigned G = gridDim.x * gridDim.y * gridDim.z;
    unsigned sum, cnt, mine, sp = 0u;
    for (;;) {
        sum = 0u; cnt = 0u; mine = 0u;
#pragma unroll
        for (unsigned j = 0; j < 16; ++j) { const unsigned c = xb_ld(&bar[XB_XCNT(j)]); sum += c; cnt += (c > 0u) ? 1u : 0u; mine = (j == x) ? c : mine; }
        if (sum == G) break;
        __builtin_amdgcn_s_sleep(1);
        if ((++sp & 255u) == 0u) { if (xb_ld(&bar[XB_TMO])) break; if (sp > XB_SPIN_CAP) { atomicAdd(&bar[XB_TMO], 1u); break; } }
    }
    nloc = mine > 0u ? mine : 1u; nx = cnt > 0u ? cnt : 1u;
}

__device__ __forceinline__ void xcd_barrier(const XcdBarrier& b) {
    asm volatile("s_waitcnt vmcnt(0)" ::: "memory");
    __syncthreads();
    if (threadIdx.x == 0) {
        unsigned* bar = b.bar;
        __builtin_amdgcn_s_waitcnt(0);
        unsigned nloc = b.st[0], nx = b.st[1];
        if (nloc == 0u) { xcd_barrier_complete(bar, b.x, nloc, nx); b.st[0] = nloc; b.st[1] = nx; }
        const unsigned old = xb_add(&bar[XB_XSUB(b.x)], 1u);
        const unsigned gen = old / nloc;
        if (old + 1u == (gen + 1u) * nloc) {
            __builtin_amdgcn_fence(__ATOMIC_RELEASE, "agent");
            asm volatile("s_waitcnt vmcnt(0)" ::: "memory");
            const unsigned og = xb_add(&bar[XB_TOP], 1u);
            const unsigned tg = og / nx;
            if (og + 1u == (tg + 1u) * nx) xb_add(&bar[XB_TOPGEN], 1u);
            else XB_SPIN(xb_ld(&bar[XB_TOPGEN]) == tg, bar);
            __builtin_amdgcn_fence(__ATOMIC_ACQUIRE, "agent");
            xb_add(&bar[XB_XGEN(b.x)], 1u);
            asm volatile("s_waitcnt vmcnt(0)" ::: "memory");
        } else {
            XB_SPIN(xb_ld(&bar[XB_XGEN(b.x)]) == gen, bar);
            __builtin_amdgcn_fence(__ATOMIC_ACQUIRE, "agent");
            asm volatile("s_waitcnt vmcnt(0)" ::: "memory");
        }
    }
    __syncthreads();
}


namespace pg8 {
constexpr int BM = 256, BK = 64, HALF = 128, HTB = HALF * BK * 2, STAGE_BYTES = 8 * HTB, NXCD = 8, WGM = 8;
__host__ __device__ __forceinline__ int lds_byte(int r, int c) { const int st = (r >> 4) * 2 + (c >> 5), rr = r & 15, cc = c & 31, ob = rr * 64 + cc * 2; return st * 1024 + (ob ^ (((ob >> 9) & 1) << 5)); }
__host__ __device__ __forceinline__ void stage_rc(int b, int& R, int& C) { const int st = b / 1024, sb = b % 1024, swz = sb ^ (((sb >> 9) & 1) << 5); R = (st >> 1) * 16 + swz / 64; C = (st & 1) * 32 + (swz % 64) / 2; }
struct Unit { int pm, pn; };
struct Gemm { const bf16* A; const bf16* Bt; int M, N, K; };
struct StaticOrder {
    int nM, nN, nwg, G, c;
    __host__ __device__ __forceinline__ void init(int M, int N, int G_, int c_) { nM = M / BM; nN = N / BM; nwg = nM * nN; G = G_; c = c_; }
    __host__ __device__ __forceinline__ bool next(int i, Unit& u) const {
        const long L = (long)i * G + c; if (L >= nwg) return false;
        int wgid = (int)L; { const int q = nwg / NXCD, r = nwg % NXCD, xcd = wgid % NXCD, off = wgid / NXCD; wgid = (xcd < r ? xcd * (q + 1) : r * (q + 1) + (xcd - r) * q) + off; }
        const int nig = WGM * nN, gid = wgid / nig, fm = gid * WGM, gsz = (nM - fm) < WGM ? (nM - fm) : WGM;
        u.pm = fm + ((wgid % nig) % gsz); u.pn = (wgid % nig) / gsz; return true;
    }
};
template <bool PAIR, class F>
__device__ __forceinline__ void epi256(const f32x4 (&acc)[2][2][4][2], const Unit& u, int wr, int wc, int fr, int fq, const F& f, LAS float* red, int tid, bool fill) {
    LAS float* rtab = red + 1600;
    if (F::HAS_RS && fill) { if (tid < 256) rtab[tid] = f.row_begin(u.pm * BM + tid);
        asm volatile("s_waitcnt lgkmcnt(0)" ::: "memory"); __builtin_amdgcn_s_barrier(); asm volatile("" ::: "memory"); }
    if constexpr (F::QKN) {
        if (u.pn < 8) {
            LAS float* r2 = red - 4096;
#pragma unroll
            for (int ai = 0; ai < 2; ++ai)
#pragma unroll
                for (int m = 0; m < 4; ++m) { const int rl = ai * HALF + wr * 64 + m * 16 + fr; const float rs = rtab[rl];
#pragma unroll
                    for (int bj = 0; bj < 2; ++bj) { const f32x4 a = acc[ai][bj][m][0] * rs, b = acc[ai][bj][m][1] * rs; float ss = sumsq4(a) + sumsq4(b);
                        ss += __shfl_xor(ss, 16); ss += __shfl_xor(ss, 32); if (fq == 0) r2[(rl * 2 + bj) * 4 + wc] = ss; } }
            asm volatile("s_waitcnt lgkmcnt(0)" ::: "memory"); __builtin_amdgcn_s_barrier(); asm volatile("" ::: "memory");
            const bool isq = u.pn < 4; const float* gv = isq ? f.gq : f.gk;
#pragma unroll
            for (int ai = 0; ai < 2; ++ai)
#pragma unroll
                for (int m = 0; m < 4; ++m) { const int rl = ai * HALF + wr * 64 + m * 16 + fr, row = u.pm * BM + rl; const float rs = rtab[rl];
#pragma unroll
                    for (int bj = 0; bj < 2; ++bj) { const f32x4 p4 = *(const LAS f32x4*)(r2 + (rl * 2 + bj) * 4);
                        const float sc = rs * rsqrtf(((p4.x + p4.y) + (p4.z + p4.w)) * (1.0f / HD) + EPS) * (isq ? QSCALE : 1.0f);
#pragma unroll
                        for (int n = 0; n < 2; ++n) { const int d = wc * 32 + n * 16 + 4 * fq, col = (u.pn & 3) * BM + bj * HALF + d; const f32x4 o = acc[ai][bj][m][n] * sc * *(const f32x4*)(gv + d);
                            if (isq) st_bf4(f.qb + (size_t)row * AW + col, o);
                            else { *(f32x4*)(f.kP + (size_t)row * AW + col) = o; st_bf4(f.kb + (size_t)row * AW + col, o); } } }
                    if (m & 1) asm volatile("" ::: "memory"); }
            return;
        }
    }
#pragma unroll
    for (int ai = 0; ai < 2; ++ai)
#pragma unroll
        for (int m = 0; m < 4; ++m) {
            const int rl = ai * HALF + wr * 64 + m * 16 + fr, row = u.pm * BM + rl; const float rs = F::HAS_RS ? rtab[rl] : 1.f; float ss = 0.f;
            if constexpr (PAIR) {
#pragma unroll
                for (int n = 0; n < 2; ++n) ss += f.apply2(rs, row, u.pn * HALF + wc * 32 + n * 16 + 4 * fq, acc[ai][0][m][n], acc[ai][1][m][n]);
            } else {
#pragma unroll
                for (int bj = 0; bj < 2; ++bj)
#pragma unroll
                    for (int n = 0; n < 2; ++n) ss += f.apply(rs, row, u.pn * BM + bj * HALF + wc * 32 + n * 16 + 4 * fq, acc[ai][bj][m][n]);
            }
            if (F::STATS) { ss += __shfl_xor(ss, 16); ss += __shfl_xor(ss, 32); if (fq == 0) red[rl * 4 + wc] = ss; }
            if (m == 3) asm volatile("" ::: "memory");
        }
    if (F::STATS) {
        asm volatile("s_waitcnt lgkmcnt(0)" ::: "memory"); __builtin_amdgcn_s_barrier(); asm volatile("" ::: "memory");
        if (tid < 256) { const f32x4 p = *(const LAS f32x4*)(red + tid * 4); f.st[(size_t)(u.pm * BM + tid) * SS + u.pn] = (p.x + p.y) + (p.z + p.w); }
    }
}
template <bool PAIR, class F>
__device__ __forceinline__ void gemm_phase(LAS unsigned char* lds, LAS float* red, const Gemm g, const StaticOrder& S, const F& E, int tid) {
    asm volatile("" : "+v"(tid));
    const int wid = __builtin_amdgcn_readfirstlane(tid >> 6), lane = tid & 63, wr = wid >> 2, wc = wid & 3, fr = lane & 15, fq = lane >> 4;
    const int K = g.K, nt = K / BK;
    unsigned voffA[2];
#pragma unroll
    for (int i = 0; i < 2; ++i) { int R, C; stage_rc(tid * 16 + i * 8192, R, C); voffA[i] = (unsigned)(R * K + C) * 2u; }
    const size_t kstep = (size_t)(BK * 2), hstep = (size_t)HALF * K * 2, tstep = 2 * hstep;
    const unsigned ldsw = (unsigned)wid * 1024u;
    const int aoff = lds_byte(wr * 64 + fr, fq * 8), boff = lds_byte(wc * 32 + fr, fq * 8);
#define PG8_SA(b, h) (((b) * 2 + (h)) * HTB)
#define PG8_SB(b, h) ((4 + (b) * 2 + (h)) * HTB)
#define PG8_STAGE(bufoff, gbase) do { _Pragma("unroll") for (int _i = 0; _i < 2; ++_i) \
        __builtin_amdgcn_global_load_lds((const unsigned*)((const char*)(gbase) + voffA[_i]), (LAS unsigned*)(lds + (bufoff) + ldsw + _i * 8192), 16, 0, 0); } while (0)
#define PG8_LDA(dst, b, h) do { _Pragma("unroll") for (int m = 0; m < 4; ++m) _Pragma("unroll") for (int k = 0; k < 2; ++k) dst[m][k] = *(const LAS bf16x8*)(lds + PG8_SA(b, h) + aoff + m * 2048 + k * 1024); } while (0)
#define PG8_LDB(dst, b, h) do { _Pragma("unroll") for (int n = 0; n < 2; ++n) _Pragma("unroll") for (int k = 0; k < 2; ++k) dst[n][k] = *(const LAS bf16x8*)(lds + PG8_SB(b, h) + boff + n * 2048 + k * 1024); } while (0)
#define PG8_MMA(ai, bj, At, Bt) do { __builtin_amdgcn_s_setprio(1); _Pragma("unroll") for (int m = 0; m < 4; ++m) _Pragma("unroll") for (int n = 0; n < 2; ++n) _Pragma("unroll") for (int k = 0; k < 2; ++k) \
        acc[ai][bj][m][n] = __builtin_amdgcn_mfma_f32_16x16x32_bf16(Bt[n][k], At[m][k], acc[ai][bj][m][n], 0, 0, 0); __builtin_amdgcn_s_setprio(0); } while (0)
#define PG8_WAIT_V(n) asm volatile("s_waitcnt vmcnt(" #n ")" ::: "memory")
#define PG8_WAIT_L(n) asm volatile("s_waitcnt lgkmcnt(" #n ")" ::: "memory")
#define PG8_BAR __builtin_amdgcn_s_barrier()
#define PG8_SCHED __builtin_amdgcn_sched_barrier(0)
    Unit cur, nxt; int ui = 0, rt_pm = -1;
    if (!S.next(0, cur)) return;
    f32x4 acc[2][2][4][2];
#pragma unroll
    for (int a = 0; a < 2; ++a)
#pragma unroll
        for (int b = 0; b < 2; ++b)
#pragma unroll
            for (int m = 0; m < 4; ++m)
#pragma unroll
                for (int n = 0; n < 2; ++n) acc[a][b][m][n] = (f32x4){0.f, 0.f, 0.f, 0.f};
    bf16x8 At[4][2], B0[2][2], B1[2][2];
    const char* cA = (const char*)g.A + (size_t)cur.pm * tstep; const char* cB = (const char*)g.Bt + (size_t)cur.pn * tstep;
    PG8_STAGE(PG8_SB(0, 0), cB); PG8_STAGE(PG8_SB(0, 1), cB + hstep); PG8_STAGE(PG8_SA(0, 0), cA); PG8_STAGE(PG8_SA(0, 1), cA + hstep);
    if (wr == 1) PG8_BAR;
    PG8_WAIT_V(2); PG8_BAR;
    PG8_STAGE(PG8_SB(1, 0), cB + kstep); PG8_STAGE(PG8_SA(1, 0), cA + kstep); PG8_STAGE(PG8_SB(1, 1), cB + hstep + kstep);
    PG8_WAIT_V(6); PG8_BAR;
    for (;;) {
        const bool has_next = S.next(ui + 1, nxt);
        const char* nA = has_next ? (const char*)g.A + (size_t)nxt.pm * tstep : cA; const char* nB = has_next ? (const char*)g.Bt + (size_t)nxt.pn * tstep : cB;
        for (int t = 0; t < nt; t += 2) {
            const bool last = (t == nt - 2);
            const char* a1 = cA + (size_t)(t + 1) * kstep;
            const char* a2 = last ? nA : cA + (size_t)(t + 2) * kstep; const char* b2 = last ? nB : cB + (size_t)(t + 2) * kstep;
            const char* a3 = a2 + kstep; const char* b3 = b2 + kstep;
            if constexpr (F::MID) { if (t == nt / 2) {
#pragma unroll
                for (int ai = 0; ai < 2; ++ai)
#pragma unroll
                    for (int m = 0; m < 4; ++m) { const float sc = E.mid_tab[ui * BM + ai * HALF + wr * 64 + m * 16 + fr];
#pragma unroll
                        for (int bj = 0; bj < 2; ++bj)
#pragma unroll
                            for (int n = 0; n < 2; ++n) acc[ai][bj][m][n] = acc[ai][bj][m][n] * sc; }
            } }
            PG8_LDB(B0, 0, 0); PG8_LDB(B1, 0, 1); PG8_SCHED; PG8_LDA(At, 0, 0); PG8_STAGE(PG8_SA(1, 1), a1 + hstep);
            PG8_WAIT_V(8); PG8_WAIT_L(0); PG8_BAR; PG8_MMA(0, 0, At, B0); PG8_MMA(0, 1, At, B1); PG8_BAR; PG8_SCHED;
            PG8_LDA(At, 0, 1); PG8_STAGE(PG8_SB(0, 0), b2); PG8_STAGE(PG8_SB(0, 1), b2 + hstep); PG8_STAGE(PG8_SA(0, 0), a2);
            PG8_WAIT_V(8); PG8_WAIT_L(0); PG8_BAR; PG8_MMA(1, 0, At, B0); PG8_MMA(1, 1, At, B1); PG8_BAR; PG8_SCHED;
            PG8_LDB(B0, 1, 0); PG8_LDB(B1, 1, 1); PG8_SCHED; PG8_LDA(At, 1, 0); PG8_STAGE(PG8_SA(0, 1), a2 + hstep);
            PG8_WAIT_V(8); PG8_WAIT_L(0); PG8_BAR; PG8_MMA(0, 0, At, B0); PG8_MMA(0, 1, At, B1); PG8_BAR; PG8_SCHED;
            PG8_LDA(At, 1, 1); PG8_STAGE(PG8_SB(1, 0), b3); PG8_STAGE(PG8_SB(1, 1), b3 + hstep); PG8_STAGE(PG8_SA(1, 0), a3);
            PG8_WAIT_V(8); PG8_WAIT_L(0); PG8_BAR; PG8_MMA(1, 0, At, B0); PG8_MMA(1, 1, At, B1); PG8_BAR; PG8_SCHED;
        }
        if (wr == 0) PG8_BAR;
        epi256<PAIR>(acc, cur, wr, wc, fr, fq, E, red, tid, cur.pm != rt_pm); rt_pm = cur.pm;
        if (!has_next) break;
#pragma unroll
        for (int a = 0; a < 2; ++a)
#pragma unroll
            for (int b = 0; b < 2; ++b)
#pragma unroll
                for (int m = 0; m < 4; ++m)
#pragma unroll
                    for (int n = 0; n < 2; ++n) acc[a][b][m][n] = (f32x4){0.f, 0.f, 0.f, 0.f};
        cur = nxt; cA = nA; cB = nB; ++ui;
        if (wr == 1) PG8_BAR;
    }
    PG8_WAIT_V(0);
    PG8_BAR;
#undef PG8_SA
#undef PG8_SB
#undef PG8_STAGE
#undef PG8_LDA
#undef PG8_LDB
#undef PG8_MMA
#undef PG8_WAIT_V
#undef PG8_WAIT_L
#undef PG8_BAR
#undef PG8_SCHED
}
}

namespace att {
typedef short v4i16_t __attribute__((ext_vector_type(4)));
__device__ __forceinline__ int kswz(int row, int colB) { return row * 256 + (colB ^ ((row & 7) << 4)); }
__device__ __forceinline__ s16x4 vtr(const LAS unsigned char* p) { return __builtin_bit_cast(s16x4, __builtin_amdgcn_ds_read_tr16_b64_v4i16((LAS v4i16_t*)p)); }
__device__ __forceinline__ bf16x8 pack8(const f32x16& p, int b) {
    u32x4 w; w.x = cvtpk(p[b + 0], p[b + 1]); w.y = cvtpk(p[b + 2], p[b + 3]); w.z = cvtpk(p[b + 4], p[b + 5]); w.w = cvtpk(p[b + 6], p[b + 7]); return __builtin_bit_cast(bf16x8, w);
}
struct State { f32x16 o[4]; float m, l; };
template <int NBK, int VBS, bool MASK>
__device__ __forceinline__ void tile(State& S, const bf16x8 (&qr)[8], const LAS unsigned char* Kb, const LAS unsigned char* Vb, const LAS float* ckp, float cq, int dq, int lane) {
    const int r32 = lane & 31, h2 = lane >> 5;
    f32x16 p[NBK];
#pragma unroll
    for (int nb = 0; nb < NBK; ++nb) p[nb] = (f32x16){0.f, 0.f, 0.f, 0.f, 0.f, 0.f, 0.f, 0.f, 0.f, 0.f, 0.f, 0.f, 0.f, 0.f, 0.f, 0.f};
    const int kx = (r32 & 7) << 4;
    const LAS unsigned char* kp4[4];
#pragma unroll
    for (int j = 0; j < 4; ++j) kp4[j] = Kb + r32 * 256 + ((32 * j + 16 * h2) ^ kx);
#pragma unroll
    for (int kq = 0; kq < 4; ++kq) {
        bf16x8 kf[2][NBK];
#pragma unroll
        for (int j = 0; j < 2; ++j)
#pragma unroll
            for (int nb = 0; nb < NBK; ++nb) kf[j][nb] = *(const LAS bf16x8*)(kp4[(2 * kq + j) & 3] + ((2 * kq + j) >> 2) * 128 + nb * 8192);
#pragma unroll
        for (int j = 0; j < 2; ++j)
#pragma unroll
            for (int nb = 0; nb < NBK; ++nb) p[nb] = __builtin_amdgcn_mfma_f32_32x32x16_bf16(kf[j][nb], qr[2 * kq + j], p[nb], 0, 0, 0);
        __builtin_amdgcn_sched_barrier(0);
    }
    float mx = -__builtin_inff();
#pragma unroll
    for (int nb = 0; nb < NBK; ++nb)
#pragma unroll
        for (int g = 0; g < 4; ++g) { const f32x4 ck = *(const LAS f32x4*)(ckp + nb * 32 + 8 * g + 4 * h2);
#pragma unroll
            for (int e = 0; e < 4; ++e) { float s = p[nb][4 * g + e] + (cq - ck[e]);
                if (MASK) { const int kk = nb * 32 + 8 * g + 4 * h2 + e; if (kk > dq) s = -__builtin_inff(); }
                p[nb][4 * g + e] = s; mx = fmaxf(mx, s); } }
    __builtin_amdgcn_sched_barrier(0);
    mx = fmaxf(mx, __shfl_xor(mx, 32));
    const float mn = (mx > S.m + 8.0f) ? mx : S.m;
    const float alpha = __builtin_amdgcn_exp2f(S.m - mn); const bool resc = __any(mn != S.m); S.m = mn;
    float ls = 0.f;
#pragma unroll
    for (int nb = 0; nb < NBK; ++nb)
#pragma unroll
        for (int i = 0; i < 16; ++i) { const float e = __builtin_amdgcn_exp2f(p[nb][i] - mn); p[nb][i] = e; ls += e; }
    S.l = S.l * alpha + ls;
    if (resc) {
#pragma unroll
        for (int d = 0; d < 4; ++d)
#pragma unroll
            for (int i = 0; i < 16; ++i) S.o[d][i] *= alpha; }
    bf16x8 pa[2 * NBK];
#pragma unroll
    for (int nb = 0; nb < NBK; ++nb) { pa[2 * nb] = pack8(p[nb], 0); pa[2 * nb + 1] = pack8(p[nb], 8); }
    const LAS unsigned char* vp = Vb + (4 * h2 + ((lane >> 2) & 3)) * 64 + ((lane >> 4) & 1) * 32 + (lane & 3) * 8;
    __builtin_amdgcn_sched_barrier(0);
#pragma unroll
    for (int d = 0; d < 4; ++d) {
        s16x4 lo[2 * NBK], hi[2 * NBK];
#pragma unroll
        for (int s = 0; s < 2 * NBK; ++s) { lo[s] = vtr(vp + d * VBS + s * 1024); hi[s] = vtr(vp + d * VBS + s * 1024 + 512); }
#pragma unroll
        for (int s = 0; s < 2 * NBK; ++s) { const bf16x8 vf = (bf16x8){lo[s][0], lo[s][1], lo[s][2], lo[s][3], hi[s][0], hi[s][1], hi[s][2], hi[s][3]};
            S.o[d] = __builtin_amdgcn_mfma_f32_32x32x16_bf16(vf, pa[s], S.o[d], 0, 0, 0); }
        __builtin_amdgcn_sched_barrier(0);
    }
}
template <int VBS, bool MASK>
__device__ __forceinline__ void tile_h2(State& S, const bf16x8 (&qr)[8], const LAS unsigned char* Kb, const LAS unsigned char* Vb, const LAS float* ckp, float cq, int dq, int lane) {
    const int r32 = lane & 31, h2 = lane >> 5, kx = (r32 & 7) << 4;
    const f32x16 z16 = (f32x16){0.f, 0.f, 0.f, 0.f, 0.f, 0.f, 0.f, 0.f, 0.f, 0.f, 0.f, 0.f, 0.f, 0.f, 0.f, 0.f};
    f32x16 p[2] = {z16, z16};
    const LAS unsigned char* kp4[4];
#pragma unroll
    for (int j = 0; j < 4; ++j) kp4[j] = Kb + r32 * 256 + ((32 * j + 16 * h2) ^ kx);
#pragma unroll
    for (int nb = 0; nb < 2; ++nb) {
#pragma unroll
        for (int kq = 0; kq < 2; ++kq) { bf16x8 kf[4];
#pragma unroll
            for (int j = 0; j < 4; ++j) kf[j] = *(const LAS bf16x8*)(kp4[j] + kq * 128 + nb * 8192);
#pragma unroll
            for (int j = 0; j < 4; ++j) p[nb] = __builtin_amdgcn_mfma_f32_32x32x16_bf16(kf[j], qr[4 * kq + j], p[nb], 0, 0, 0); }
    }
    const LAS unsigned char* vp = Vb + (4 * h2 + ((lane >> 2) & 3)) * 64 + ((lane >> 4) & 1) * 32 + (lane & 3) * 8;
#pragma unroll
    for (int nb = 0; nb < 2; ++nb) {
        float mx = -__builtin_inff();
#pragma unroll
        for (int g = 0; g < 4; ++g) { const f32x4 ck = *(const LAS f32x4*)(ckp + nb * 32 + 8 * g + 4 * h2);
#pragma unroll
            for (int e = 0; e < 4; ++e) { float s = p[nb][4 * g + e] + (cq - ck[e]);
                if (MASK) { const int kk = nb * 32 + 8 * g + 4 * h2 + e; if (kk > dq) s = -__builtin_inff(); }
                p[nb][4 * g + e] = s; mx = fmaxf(mx, s); } }
        mx = fmaxf(mx, __shfl_xor(mx, 32));
        const float mn = (mx > S.m + 8.0f) ? mx : S.m;
        const float alpha = __builtin_amdgcn_exp2f(S.m - mn); const bool resc = __any(mn != S.m); S.m = mn;
        float ls = 0.f;
#pragma unroll
        for (int i = 0; i < 16; ++i) { const float e = __builtin_amdgcn_exp2f(p[nb][i] - mn); p[nb][i] = e; ls += e; }
        S.l = S.l * alpha + ls;
        if (resc) {
#pragma unroll
            for (int d = 0; d < 4; ++d)
#pragma unroll
                for (int i = 0; i < 16; ++i) S.o[d][i] *= alpha; }
        const bf16x8 pa0 = pack8(p[nb], 0), pa1 = pack8(p[nb], 8);
#pragma unroll
        for (int d = 0; d < 4; ++d) {
            const s16x4 l0 = vtr(vp + d * VBS + (2 * nb) * 1024), h0 = vtr(vp + d * VBS + (2 * nb) * 1024 + 512), l1 = vtr(vp + d * VBS + (2 * nb + 1) * 1024), h1 = vtr(vp + d * VBS + (2 * nb + 1) * 1024 + 512);
            S.o[d] = __builtin_amdgcn_mfma_f32_32x32x16_bf16((bf16x8){l0[0], l0[1], l0[2], l0[3], h0[0], h0[1], h0[2], h0[3]}, pa0, S.o[d], 0, 0, 0);
            S.o[d] = __builtin_amdgcn_mfma_f32_32x32x16_bf16((bf16x8){l1[0], l1[1], l1[2], l1[3], h1[0], h1[1], h1[2], h1[3]}, pa1, S.o[d], 0, 0, 0); }
    }
}
template <int PER, class LD>
__device__ __forceinline__ void cumsum_lds(LAS float* cl, LAS float* scr, int n, int tid, const LD& ld) {
    asm volatile("" : "+v"(tid));
    const int lane = tid & 63, wave = tid >> 6; float v[PER]; float tot = 0.f;
#pragma unroll
    for (int e = 0; e < PER; ++e) { const int i = tid * PER + e; v[e] = i < n ? ld(i) : 0.f; tot += v[e]; }
    float inc = tot;
#pragma unroll
    for (int o = 1; o < 64; o <<= 1) { const float t = __builtin_bit_cast(float, __builtin_amdgcn_ds_bpermute(((lane - o) & 63) << 2, __builtin_bit_cast(int, inc))); if (lane >= o) inc += t; }
    if (lane == 63) scr[wave] = inc;
    __syncthreads();
    float base = inc - tot;
    for (int w = 0; w < wave; ++w) base += scr[w];
#pragma unroll
    for (int e = 0; e < PER; ++e) { base += v[e]; const int i = tid * PER + e; if (i < n) cl[i] = base * LOG2E; }
    __syncthreads();
}

constexpr int P_K = 0, P_V = 32768, P_VBS = 4160, P_VSZ = 4 * P_VBS, P_CL = P_V + 2 * P_VSZ, P_SCR = P_CL + 8448;
constexpr int S_TILE = 16384 + P_VSZ, S_BUF = 2 * S_TILE, S_CL = 2 * S_BUF, S_SCR = S_CL + 8448, S_ML = S_SCR + 64;

__device__ __forceinline__ void attn_phase(const Ctx& c, int l, LAS unsigned char* lds, int G, int bx, int tid) {
    asm volatile("" : "+v"(tid));
    const int lane = tid & 63, wave = __builtin_amdgcn_readfirstlane(tid >> 6), r32 = lane & 31, h2 = lane >> 5;
    const bf16* qb = (const bf16*)(c.ws + WS_QB); const bf16* kb = (const bf16*)(c.ws + WS_KB); const bf16* vb = (const bf16*)(c.ws + WS_VB); bf16* mg = (bf16*)(c.ws + WS_MG); float* sta = stat_ptr(c, ST_A);
#ifndef NO_PROMPT
    for (int item = bx; item < NBAT * NH * 4; item += G) {
        const int b = item >> 5, h = (item >> 2) & 7, pr = item & 3;
        const int nqb = pr == 1 ? 3 : pr == 2 ? 1 : 2;
        LAS float* cl = (LAS float*)(lds + P_CL); const float* lf = c.out + O_LFP + (size_t)l * MP * NH + (size_t)b * SEQ * NH + h;
        cumsum_lds<4>(cl, (LAS float*)(lds + P_SCR), SEQ, tid, [&](int i) { return lf[(size_t)i * NH]; });
        for (int half = 0; half < nqb; ++half) {
            int t_ = tid; asm volatile("" : "+v"(t_));
            const int lane = t_ & 63, r32 = lane & 31, h2 = lane >> 5;
            const int qblk = pr == 0 ? (half ? 3 : 7) : pr == 1 ? (half == 0 ? 6 : half == 1 ? 2 : 1) : pr == 2 ? 5 : (half ? 0 : 4), q0 = qblk * 256, nt = 4 * (qblk + 1), qw = q0 + wave * 32;
            const size_t qrow = (size_t)b * SEQ + qw + r32;
            bf16x8 qr[8];
#pragma unroll
            for (int ks = 0; ks < 8; ++ks) qr[ks] = *(const bf16x8*)(qb + qrow * AW + h * HD + 16 * ks + 8 * h2);
            const float cq = cl[qw + r32];
            State S;
#pragma unroll
            for (int d = 0; d < 4; ++d) S.o[d] = (f32x16){0.f, 0.f, 0.f, 0.f, 0.f, 0.f, 0.f, 0.f, 0.f, 0.f, 0.f, 0.f, 0.f, 0.f, 0.f, 0.f};
            S.m = -1e30f; S.l = 0.f;
            const int krow = 4 * wave + (lane >> 4);
            const bf16* kg = kb + ((size_t)b * SEQ + krow) * AW + h * HD + 8 * ((lane & 15) ^ (krow & 7));
            const bf16* vg = vb + ((size_t)b * SEQ + 32 * (wave & 1) + (lane >> 2)) * AW + h * HD + 32 * (wave >> 1) + 8 * (lane & 3);
            const int kdst = P_K + wave * 1024, vdst = P_V + (wave >> 1) * P_VBS + (wave & 1) * 2048;
#define ATT_STAGE(buf, k0_) do { const size_t o_ = (size_t)(k0_) * AW; \
                __builtin_amdgcn_global_load_lds((const unsigned*)(kg + o_), (LAS unsigned*)(lds + kdst + (buf) * 16384), 16, 0, 0); \
                __builtin_amdgcn_global_load_lds((const unsigned*)(kg + o_ + 32 * AW), (LAS unsigned*)(lds + kdst + (buf) * 16384 + 8192), 16, 0, 0); \
                __builtin_amdgcn_global_load_lds((const unsigned*)(vg + o_), (LAS unsigned*)(lds + vdst + (buf) * P_VSZ), 16, 0, 0); \
                __builtin_amdgcn_global_load_lds((const unsigned*)(vg + o_ + 16 * AW), (LAS unsigned*)(lds + vdst + (buf) * P_VSZ + 1024), 16, 0, 0); } while (0)
            ATT_STAGE(0, 0);
            asm volatile("s_waitcnt vmcnt(0)" ::: "memory"); __syncthreads();
            for (int t = 0; t < nt; ++t) {
                const int cur = t & 1, k0 = 64 * t;
                if (t + 1 < nt) ATT_STAGE(cur ^ 1, k0 + 64);
                if (k0 <= qw + 31) {
                    const LAS unsigned char* Kb = lds + P_K + cur * 16384; const LAS unsigned char* Vb = lds + P_V + cur * P_VSZ;
                    if (k0 + 63 > qw) tile_h2<P_VBS, true>(S, qr, Kb, Vb, cl + k0, cq, qw + r32 - k0, lane);
                    else tile_h2<P_VBS, false>(S, qr, Kb, Vb, cl + k0, cq, 0, lane);
                }
                asm volatile("s_waitcnt vmcnt(0)" ::: "memory"); __syncthreads();
            }
#undef ATT_STAGE
            const float lt = S.l + __shfl_xor(S.l, 32), inv = 1.0f / lt; float ss = 0.f;
            bf16* op = mg + qrow * D + h * HD + 4 * h2;
#pragma unroll
            for (int d = 0; d < 4; ++d)
#pragma unroll
                for (int g = 0; g < 4; ++g) { const f32x4 v = (f32x4){S.o[d][4 * g] * inv, S.o[d][4 * g + 1] * inv, S.o[d][4 * g + 2] * inv, S.o[d][4 * g + 3] * inv}; ss += sumsq4(v); st_bf4(op + 32 * d + 8 * g, v); }
            ss += __shfl_xor(ss, 32); if (h2 == 0) sta[qrow * SS + h] = ss;
        }
    }
#endif
#ifndef NO_SAMPLE
    for (int pit = bx; pit < NBAT * NH * 4; pit += G) {
        if ((pit & 3) < 2) continue;
        const int item = (pit >> 2) * 2 + (pit & 1), b = item >> 3, h = item & 7;
        LAS float* cl = (LAS float*)(lds + P_CL);
        const float* lfc = c.in[4] + ((size_t)l * DBAT + b) * PAST * NH + h; const float* lfn = c.out + O_LFS + ((size_t)l * MS + b * DSEQ) * NH + h;
        cumsum_lds<5>(cl, (LAS float*)(lds + P_SCR), PAST + DSEQ, tid, [&](int i) { return i < PAST ? lfc[(size_t)i * NH] : lfn[(size_t)(i - PAST) * NH]; });
        int t_ = tid; asm volatile("" : "+v"(t_));
        const int lane = t_ & 63, r32 = lane & 31, h2 = lane >> 5;
        const int qi = r32 & 15; const size_t qrow = (size_t)MP + b * DSEQ + qi;
        bf16x8 qr[8];
#pragma unroll
        for (int ks = 0; ks < 8; ++ks) qr[ks] = *(const bf16x8*)(qb + qrow * AW + h * HD + 16 * ks + 8 * h2);
        const float cq = cl[PAST + qi];
        State S;
#pragma unroll
        for (int d = 0; d < 4; ++d) S.o[d] = (f32x16){0.f, 0.f, 0.f, 0.f, 0.f, 0.f, 0.f, 0.f, 0.f, 0.f, 0.f, 0.f, 0.f, 0.f, 0.f, 0.f};
        S.m = -1e30f; S.l = 0.f;
        const float* kg0 = c.in[2] + (((size_t)l * DBAT + b) * PAST) * AW + h * HD; const float* vg0 = c.in[3] + (((size_t)l * DBAT + b) * PAST) * AW + h * HD;
        const bf16* kn0 = kb + ((size_t)MP + b * DSEQ) * AW + h * HD; const bf16* vn0 = vb + ((size_t)MP + b * DSEQ) * AW + h * HD;
#define SMP_LOAD(R, tn) do { int x_ = t_ - 128; asm volatile("" : "+v"(x_)); \
            _Pragma("unroll") for (int ps = 0; ps < 6; ++ps) { const int ci = x_ + 384 * ps; R[2 * ps] = (f32x4){0.f, 0.f, 0.f, 0.f}; R[2 * ps + 1] = R[2 * ps]; if (ci < 2048) { const int isv = ci >> 10, row = (ci >> 4) & 63, ch = ci & 15; \
                if ((tn) < 32) { const float* src = (isv ? vg0 : kg0) + (size_t)(64 * (tn) + row) * AW + 8 * ch; R[2 * ps] = *(const f32x4*)src; R[2 * ps + 1] = *(const f32x4*)(src + 4); } \
                else if (row < DSEQ) R[2 * ps] = __builtin_bit_cast(f32x4, *(const u32x4*)((isv ? vn0 : kn0) + (size_t)row * AW + 8 * ch)); } } } while (0)
#define SMP_WRITE(R, tn, buf) do { int x_ = t_ - 128; asm volatile("" : "+v"(x_)); \
            _Pragma("unroll") for (int ps = 0; ps < 6; ++ps) { const int ci = x_ + 384 * ps; if (ci < 2048) { const int isv = ci >> 10, row = (ci >> 4) & 63, ch = ci & 15; u32x4 w_; \
                if ((tn) < 32) { w_.x = cvtpk(R[2 * ps].x, R[2 * ps].y); w_.y = cvtpk(R[2 * ps].z, R[2 * ps].w); w_.z = cvtpk(R[2 * ps + 1].x, R[2 * ps + 1].y); w_.w = cvtpk(R[2 * ps + 1].z, R[2 * ps + 1].w); } \
                else w_ = __builtin_bit_cast(u32x4, R[2 * ps]); \
                if (isv) *(LAS u32x4*)(lds + P_V + (buf) * P_VSZ + (ch >> 2) * P_VBS + row * 64 + (ch & 3) * 16) = w_; else *(LAS u32x4*)(lds + P_K + (buf) * 16384 + kswz(row, ch * 16)) = w_; } } } while (0)
#define SMP_BAR() do { asm volatile("s_waitcnt lgkmcnt(0)" ::: "memory"); __builtin_amdgcn_s_barrier(); asm volatile("" ::: "memory"); } while (0)
        if (wave < 2) {
            SMP_BAR();
            for (int t = 0; t < 33; ++t) { const int cur = t & 1;
                const LAS unsigned char* Kb = lds + P_K + cur * 16384 + wave * 8192; const LAS unsigned char* Vb = lds + P_V + cur * P_VSZ + wave * 2048;
                if (t < 32) tile<1, P_VBS, false>(S, qr, Kb, Vb, cl + 64 * t + 32 * wave, cq, 0, lane);
                else if (wave == 0) tile<1, P_VBS, true>(S, qr, Kb, Vb, cl + PAST, cq, qi, lane);
                SMP_BAR(); }
        } else {
            f32x4 RA[12], RB[12];
            SMP_LOAD(RA, 0); SMP_WRITE(RA, 0, 0); SMP_LOAD(RA, 1); SMP_LOAD(RB, 2);
            SMP_BAR();
#define SMP_STEP(R, t) do { if ((t) + 1 < 33) SMP_WRITE(R, (t) + 1, ((t) & 1) ^ 1); if ((t) + 3 < 33) SMP_LOAD(R, (t) + 3); SMP_BAR(); } while (0)
            for (int t = 0; t < 32; t += 2) { SMP_STEP(RA, t); SMP_STEP(RB, t + 1); }
            SMP_STEP(RA, 32);
        }
        asm volatile("s_waitcnt vmcnt(0)" ::: "memory");
#undef SMP_BAR
#undef SMP_STEP
#undef SMP_LOAD
#undef SMP_WRITE
        const float lt = S.l + __shfl_xor(S.l, 32);
        LAS float* cmb = (LAS float*)lds; LAS float* ml = (LAS float*)(lds + 32768);
        int u_ = tid; asm volatile("" : "+v"(u_));
        { const int r32 = u_ & 31, h2 = (u_ >> 5) & 1;
        if (wave < 2 && r32 < 16) {
#pragma unroll
            for (int d = 0; d < 4; ++d)
#pragma unroll
                for (int g = 0; g < 4; ++g) *(LAS f32x4*)(cmb + (wave * 16 + r32) * 128 + 32 * d + 8 * g + 4 * h2) = (f32x4){S.o[d][4 * g], S.o[d][4 * g + 1], S.o[d][4 * g + 2], S.o[d][4 * g + 3]};
            if (h2 == 0) { ml[(wave * 16 + r32) * 2] = S.m; ml[(wave * 16 + r32) * 2 + 1] = lt; }
        } }
        __syncthreads();
        { const int q = u_ >> 5, d4 = (u_ & 31) * 4;
          const float m0 = ml[q * 2], m1 = ml[(16 + q) * 2], M = fmaxf(m0, m1), f0 = __builtin_amdgcn_exp2f(m0 - M), f1 = __builtin_amdgcn_exp2f(m1 - M);
          const float L = ml[q * 2 + 1] * f0 + ml[(16 + q) * 2 + 1] * f1;
          f32x4 acc = *(const LAS f32x4*)(cmb + q * 128 + d4) * f0 + *(const LAS f32x4*)(cmb + (16 + q) * 128 + d4) * f1;
          const float inv = 1.0f / L; acc = acc * inv;
          const size_t orow = (size_t)MP + b * DSEQ + q; st_bf4(mg + orow * D + h * HD + d4, acc);
          float ss = sumsq4(acc);
#pragma unroll
          for (int k = 1; k < 32; k <<= 1) ss += __builtin_bit_cast(float, __builtin_amdgcn_ds_bpermute(((u_ & 63) ^ k) << 2, __builtin_bit_cast(int, ss)));
          if ((u_ & 31) == 0) sta[orow * SS + h] = ss; }
        __syncthreads();
    }
#endif
}
}

namespace ssm {
constexpr int IMB = 6144, IMW = 2 * IMB, E_OFF = 8 * IMW;
constexpr int IM_C = 40, IM_G = 8 * IM_C, IM_P = 4 * IM_G;
struct Cx { float r0, i0, r1, i1; };
__device__ __forceinline__ float afma(float a, float b, float c) { float d; asm("v_fma_f32 %0, %1, %2, %3" : "=v"(d) : "v"(a), "v"(b), "v"(c)); return d; }
__device__ __forceinline__ float idv(float a) { return __builtin_amdgcn_fmed3f(a, a, a); }
template <bool OUT>
__device__ __forceinline__ void chunk(const bf16* ub, bf16* gs, size_t ubase0, size_t ubase1, size_t grow0, size_t grow1, int t0, int nsteps, const bf16x8 (&bfr)[4], const bf16x8 (&cfr)[4],
                                      float ar0, float ai0, float ar1, float ai1, f32x4 dsk, Cx& x, LAS unsigned char* img, int lane) {
    asm volatile("" : "+v"(lane));
    const int r32 = lane & 31, h2 = lane >> 5, quad = lane >> 4, c16 = lane & 15;
    const int bsel = (r32 >> 2) & 1, ti = (r32 & 3) + 4 * (r32 >> 3);
    const bf16* up = ub + (bsel ? ubase1 : ubase0) + (size_t)(t0 + ti) * 16 + 8 * h2;
    LAS unsigned char* wp = img + (r32 >> 3) * IM_G + (r32 & 7) * IM_C + 8 * h2;
    const LAS unsigned char* rp = img + quad * IM_G + ((lane >> 2) & 3) * IM_C + (lane & 3) * 8;
    const f32x16 z16 = (f32x16){0.f, 0.f, 0.f, 0.f, 0.f, 0.f, 0.f, 0.f, 0.f, 0.f, 0.f, 0.f, 0.f, 0.f, 0.f, 0.f};
    const float nai0 = -ai0, nai1 = -ai1;
    bf16x8 ufn = *(const bf16x8*)up;
    for (int s = 0; s < nsteps; ++s) {
        const bf16x8 uf = ufn;
        if (s + 1 < nsteps) ufn = *(const bf16x8*)(up + (size_t)(s + 1) * 256);
        u32x2 uw[2];
        if (OUT) {
#pragma unroll
            for (int mb = 0; mb < 2; ++mb) { const int tok = t0 + 16 * s + 4 * (2 * mb + (c16 >> 3)) + (c16 & 3); const size_t ubq = ((c16 >> 2) & 1) ? ubase1 : ubase0;
                uw[mb] = *(const u32x2*)(ub + ubq + (size_t)tok * 16 + 4 * quad); }
        }
        f32x16 a0 = __builtin_amdgcn_mfma_f32_32x32x16_bf16(uf, bfr[0], z16, 0, 0, 0), a1 = __builtin_amdgcn_mfma_f32_32x32x16_bf16(uf, bfr[1], z16, 0, 0, 0);
        f32x16 a2 = __builtin_amdgcn_mfma_f32_32x32x16_bf16(uf, bfr[2], z16, 0, 0, 0), a3 = __builtin_amdgcn_mfma_f32_32x32x16_bf16(uf, bfr[3], z16, 0, 0, 0);
#pragma unroll
        for (int i = 0; i < 16; ++i) {
            const float n0r = afma(ar0, x.r0, afma(nai0, x.i0, idv(a0[i]))), n0i = afma(ar0, x.i0, afma(ai0, x.r0, idv(a2[i]))); x.r0 = n0r; x.i0 = n0i;
            const float n1r = afma(ar1, x.r1, afma(nai1, x.i1, idv(a1[i]))), n1i = afma(ar1, x.i1, afma(ai1, x.r1, idv(a3[i]))); x.r1 = n1r; x.i1 = n1i;
            if (OUT) { a0[i] = n0r; a2[i] = n0i; a1[i] = n1r; a3[i] = n1i; }
        }
        if (OUT) {
#pragma unroll
            for (int gq = 0; gq < 4; ++gq) { const int o = (gq >> 1) * IMB + (gq & 1) * 16;
                u32x2 w; w.x = cvtpk(a0[4 * gq], a0[4 * gq + 1]); w.y = cvtpk(a0[4 * gq + 2], a0[4 * gq + 3]); *(LAS u32x2*)(wp + o) = w;
                w.x = cvtpk(a1[4 * gq], a1[4 * gq + 1]); w.y = cvtpk(a1[4 * gq + 2], a1[4 * gq + 3]); *(LAS u32x2*)(wp + o + IM_P) = w;
                w.x = cvtpk(a2[4 * gq], a2[4 * gq + 1]); w.y = cvtpk(a2[4 * gq + 2], a2[4 * gq + 3]); *(LAS u32x2*)(wp + o + 2 * IM_P) = w;
                w.x = cvtpk(a3[4 * gq], a3[4 * gq + 1]); w.y = cvtpk(a3[4 * gq + 2], a3[4 * gq + 3]); *(LAS u32x2*)(wp + o + 3 * IM_P) = w; }
            asm volatile("s_waitcnt lgkmcnt(0)" ::: "memory");
#pragma unroll
            for (int mb = 0; mb < 2; ++mb) {
                f32x4 y = (f32x4){0.f, 0.f, 0.f, 0.f};
#pragma unroll
                for (int ks = 0; ks < 4; ++ks) { const s16x4 lo = att::vtr(rp + mb * IMB + ks * IM_P), hi = att::vtr(rp + mb * IMB + ks * IM_P + 4 * IM_C);
                    const bf16x8 xf = (bf16x8){lo[0], lo[1], lo[2], lo[3], hi[0], hi[1], hi[2], hi[3]};
                    y = __builtin_amdgcn_mfma_f32_16x16x32_bf16(cfr[ks], xf, y, 0, 0, 0); }
                const int tok = t0 + 16 * s + 4 * (2 * mb + (c16 >> 3)) + (c16 & 3); const size_t grq = ((c16 >> 2) & 1) ? grow1 : grow0;
                const float v0 = gelu_tanh_(y[0] + dsk.x * bflo(uw[mb].x)), v1 = gelu_tanh_(y[1] + dsk.y * bfhi(uw[mb].x)), v2 = gelu_tanh_(y[2] + dsk.z * bflo(uw[mb].y)), v3 = gelu_tanh_(y[3] + dsk.w * bfhi(uw[mb].y));
                u32x2 o; o.x = cvtpk(v0, v1); o.y = cvtpk(v2, v3); *(u32x2*)(gs + (grq + tok) * SW + 4 * quad) = o;
            }
            asm volatile("s_waitcnt lgkmcnt(0)" ::: "memory");
        }
    }
}
__device__ __forceinline__ void ssm_phase(const Ctx& c, int l, LAS unsigned char* lds, int G, int bx, int tid) {
    asm volatile("" : "+v"(tid));
    const int lane = tid & 63, wave = __builtin_amdgcn_readfirstlane(tid >> 6), r32 = lane & 31, h2 = lane >> 5, quad = lane >> 4, c16 = lane & 15;
    const Lw w = layer_w(c, l); const bf16* ub = (const bf16*)(c.ws + WS_UB); bf16* gs = (bf16*)(c.ws + WS_GS);
    LAS unsigned char* img = lds + wave * IMW; LAS float* E = (LAS float*)(lds + E_OFF);
    for (int item = bx; item < NG * 4 + NG; item += G) {
        const bool smp = item >= NG * 4; const int g = smp ? item - NG * 4 : item >> 2, bp = smp ? wave : item & 3, b0 = 2 * bp, T = smp ? DSEQ : SEQ;
        bf16x8 bfr[4], cfr[4];
#pragma unroll
        for (int nb = 0; nb < 4; ++nb) bfr[nb] = *(const bf16x8*)(w.bcat + ((size_t)g * 128 + 32 * nb + r32) * 16 + 8 * h2);
#pragma unroll
        for (int ks = 0; ks < 4; ++ks) cfr[ks] = *(const bf16x8*)(w.ccat + ((size_t)g * 16 + c16) * 128 + 32 * ks + 8 * quad);
        const float ar0 = w.abr[g * NP + r32], ai0 = w.abi[g * NP + r32], ar1 = w.abr[g * NP + 32 + r32], ai1 = w.abi[g * NP + 32 + r32];
        const f32x4 dsk = *(const f32x4*)(c.in[21] + l * SW + g * 16 + 4 * quad);
        const size_t ub0 = (smp ? UB_S_OFF : 0) + ((size_t)b0 * NG + g) * T * 16, ub1 = ub0 + (size_t)NG * T * 16;
        const size_t gr0 = smp ? (size_t)MP + b0 * DSEQ : (size_t)b0 * SEQ, gr1 = gr0 + T;
        bf16* gsg = gs + g * 16;
        Cx x; x.r0 = 0.f; x.i0 = 0.f; x.r1 = 0.f; x.i1 = 0.f;
        if (!smp) {
            chunk<false>(ub, gsg, ub0, ub1, gr0, gr1, wave * 256, 16, bfr, cfr, ar0, ai0, ar1, ai1, dsk, x, img, lane);
            E[(wave * 4 + 0) * 64 + lane] = x.r0; E[(wave * 4 + 1) * 64 + lane] = x.i0; E[(wave * 4 + 2) * 64 + lane] = x.r1; E[(wave * 4 + 3) * 64 + lane] = x.i1;
            __syncthreads();
            float p0r = ar0, p0i = ai0, p1r = ar1, p1i = ai1;
#pragma unroll
            for (int k = 0; k < 8; ++k) { const float t0r = p0r * p0r - p0i * p0i, t0i = (p0r + p0r) * p0i, t1r = p1r * p1r - p1i * p1i, t1i = (p1r + p1r) * p1i; p0r = t0r; p0i = t0i; p1r = t1r; p1i = t1i; }
            x.r0 = 0.f; x.i0 = 0.f; x.r1 = 0.f; x.i1 = 0.f;
            for (int ww = 0; ww < wave; ++ww) {
                const float e0r = E[(ww * 4 + 0) * 64 + lane], e0i = E[(ww * 4 + 1) * 64 + lane], e1r = E[(ww * 4 + 2) * 64 + lane], e1i = E[(ww * 4 + 3) * 64 + lane];
                const float n0r = p0r * x.r0 - p0i * x.i0 + e0r, n0i = p0r * x.i0 + p0i * x.r0 + e0i, n1r = p1r * x.r1 - p1i * x.i1 + e1r, n1i = p1r * x.i1 + p1i * x.r1 + e1i;
                x.r0 = n0r; x.i0 = n0i; x.r1 = n1r; x.i1 = n1i; }
            chunk<true>(ub, gsg, ub0, ub1, gr0, gr1, wave * 256, 16, bfr, cfr, ar0, ai0, ar1, ai1, dsk, x, img, lane);
            __syncthreads();
        } else {
            const size_t so = (((size_t)l * DBAT + b0 + h2) * NG + g) * NP + r32;
            x.r0 = c.in[5][so]; x.i0 = c.in[6][so]; x.r1 = c.in[5][so + 32]; x.i1 = c.in[6][so + 32];
            chunk<true>(ub, gsg, ub0, ub1, gr0, gr1, 0, 1, bfr, cfr, ar0, ai0, ar1, ai1, dsk, x, img, lane);
        }
        if (smp || wave == 7) {
            float* sre = c.out + (smp ? O_SRS + (((size_t)l * DBAT + b0 + h2) * NG + g) * NP : O_SRP + (((size_t)l * NBAT + b0 + h2) * NG + g) * NP);
            float* sim = c.out + (smp ? O_SIS + (((size_t)l * DBAT + b0 + h2) * NG + g) * NP : O_SIP + (((size_t)l * NBAT + b0 + h2) * NG + g) * NP);
            sre[r32] = x.r0; sre[r32 + 32] = x.r1; sim[r32] = x.i0; sim[r32 + 32] = x.i1;
        }
    }
}
}

constexpr int SKB_STRIDE = 528, SKB_BUF = 64 * SKB_STRIDE;
template <int NB, bool PAIR, class F>
__device__ __forceinline__ void sk_gemm(LAS unsigned char* lds, const GArgs& g, const F& f, int G, int bx, int tid) {
    asm volatile("" : "+v"(tid));
    const int lane = tid & 63, wave = __builtin_amdgcn_readfirstlane(tid >> 6), r32 = lane & 31, h2 = lane >> 5, nsc = g.K / 256;
    const int scol = tid >> 3, sp = tid & 7;
    const int nunits = g.nrt * g.nct;
    __syncthreads();
    for (int u = bx; u < nunits; u += G) {
        const int tr = u / g.nct, tc = u % g.nct, row = g.r0 + 256 * tr + 32 * wave + r32;
        int nb0, nb1, colbase;
        if (PAIR) { nb0 = 256 * (tc >> 2) + 32 * (tc & 3); nb1 = nb0 + 128; colbase = 32 * tc; } else { nb0 = 32 * NB * tc; nb1 = nb0 + 32; colbase = nb0; }
        const bf16* ap = g.A + (size_t)row * g.lda + 8 * h2;
        const bf16* bg = g.Bt + (size_t)((scol < 32 ? nb0 : nb1 - 32) + scol) * g.ldb + 8 * sp;
        const bool stg = NB == 2 || scol < 32;
        LAS unsigned char* bw = lds + scol * SKB_STRIDE + sp * 16;
        const LAS unsigned char* br = lds + r32 * SKB_STRIDE + 16 * h2;
        f32x16 acc0 = {}, acc1 = {};
        bf16x8 a[16], an[16]; u32x4 bs[4], bs2[4];
#pragma unroll
        for (int i = 0; i < 4; ++i) bs[i] = stg ? *(const u32x4*)(bg + 64 * i) : (u32x4){0u, 0u, 0u, 0u};
#pragma unroll
        for (int j = 0; j < 16; ++j) a[j] = *(const bf16x8*)(ap + 16 * j);
        if (stg) {
#pragma unroll
            for (int i = 0; i < 4; ++i) *(LAS u32x4*)(bw + 128 * i) = bs[i]; }
        if (stg && nsc > 1) {
#pragma unroll
            for (int i = 0; i < 4; ++i) bs[i] = *(const u32x4*)(bg + 256 + 64 * i); }
        __syncthreads();
        const int cmid = F::MID ? g.kmid / 256 : -1;
        for (int sc = 0; sc < nsc; ++sc) {
            const int cur = sc & 1;
            if (sc + 2 < nsc && stg) {
#pragma unroll
                for (int i = 0; i < 4; ++i) bs2[i] = *(const u32x4*)(bg + 256 * (sc + 2) + 64 * i); }
            if (sc + 1 < nsc) {
#pragma unroll
                for (int j = 0; j < 16; ++j) an[j] = *(const bf16x8*)(ap + 256 * (sc + 1) + 16 * j); }
            if (F::MID && sc == cmid) { const float sm = f.mid_scale(row);
#pragma unroll
                for (int i = 0; i < 16; ++i) { acc0[i] *= sm; acc1[i] *= sm; } }
#pragma unroll
            for (int j = 0; j < 16; ++j) {
                const bf16x8 b0 = *(const LAS bf16x8*)(br + cur * SKB_BUF + 32 * j);
                acc0 = __builtin_amdgcn_mfma_f32_32x32x16_bf16(b0, a[j], acc0, 0, 0, 0);
                if (NB == 2) { const bf16x8 b1 = *(const LAS bf16x8*)(br + cur * SKB_BUF + 32 * SKB_STRIDE + 32 * j); acc1 = __builtin_amdgcn_mfma_f32_32x32x16_bf16(b1, a[j], acc1, 0, 0, 0); }
            }
            if (sc + 1 < nsc) {
                if (stg) {
#pragma unroll
                    for (int i = 0; i < 4; ++i) { *(LAS u32x4*)(bw + (cur ^ 1) * SKB_BUF + 128 * i) = bs[i]; bs[i] = bs2[i]; } }
#pragma unroll
                for (int j = 0; j < 16; ++j) a[j] = an[j]; }
            __syncthreads();
        }
        const float rs = f.row_begin(row); float ss = 0.f;
        if constexpr (PAIR) {
#pragma unroll
            for (int gq = 0; gq < 4; ++gq) ss += f.apply2(rs, row, colbase + 8 * gq + 4 * h2, (f32x4){acc0[4 * gq], acc0[4 * gq + 1], acc0[4 * gq + 2], acc0[4 * gq + 3]}, (f32x4){acc1[4 * gq], acc1[4 * gq + 1], acc1[4 * gq + 2], acc1[4 * gq + 3]});
        } else {
#pragma unroll
            for (int gq = 0; gq < 4; ++gq) ss += f.apply(rs, row, colbase + 8 * gq + 4 * h2, (f32x4){acc0[4 * gq], acc0[4 * gq + 1], acc0[4 * gq + 2], acc0[4 * gq + 3]});
            if (NB == 2) {
#pragma unroll
                for (int gq = 0; gq < 4; ++gq) ss += f.apply(rs, row, colbase + 32 + 8 * gq + 4 * h2, (f32x4){acc1[4 * gq], acc1[4 * gq + 1], acc1[4 * gq + 2], acc1[4 * gq + 3]});
            }
        }
        if (F::STATS) { ss += __shfl_xor(ss, 32); if (h2 == 0) f.st[(size_t)row * SS + tc] = ss; }
    }
}

constexpr int SQ_PITCH = 528, SQ_A = 64 * SQ_PITCH, SQ_BUF = 96 * SQ_PITCH, SQ_PP = 36;
#define SQ_BAR() asm volatile("s_waitcnt lgkmcnt(0)\n\ts_barrier" ::: "memory")
template <class F>
__device__ __forceinline__ void sq2_gemm(LAS unsigned char* lds, const GArgs& g, const F& f, int G, int bx, int tid) {
    asm volatile("" : "+v"(tid));
    const int lane = tid & 63, wave = __builtin_amdgcn_readfirstlane(tid >> 6), r32 = lane & 31, h2 = lane >> 5, rb = wave & 1, kq = wave >> 1;
    const int nsc = g.K / 256, nunits = g.nrt * g.nct;
    const int srow = tid >> 5, sp = tid & 31;
    const int cmid = F::MID ? g.kmid / 256 : -1;
    __syncthreads();
    for (int u = bx; u < nunits; u += G) {
        const int tc = u / g.nrt, rg = u % g.nrt, row0 = g.r0 + 64 * rg, nb0 = 32 * tc;
        const bf16* ag = g.A + (size_t)(row0 + srow) * g.lda + 8 * sp;
        const bf16* bg = g.Bt + (size_t)(nb0 + srow) * g.ldb + 8 * sp;
        const size_t astep = (size_t)16 * g.lda, bstep = (size_t)16 * g.ldb;
        LAS unsigned char* sw = lds + srow * SQ_PITCH + sp * 16;
        const LAS unsigned char* ar = lds + (32 * rb + r32) * SQ_PITCH + 128 * kq + 16 * h2;
        const LAS unsigned char* br = lds + SQ_A + r32 * SQ_PITCH + 128 * kq + 16 * h2;
        const int er = tid >> 3, cq = tid & 7, grow = row0 + er;
        const float rs = f.row_begin(grow);
        f32x16 acc = {};
        u32x4 s0[6], s1[6];
#define SQ_LOAD(s, c) do { _Pragma("unroll") for (int i = 0; i < 4; ++i) s[i] = *(const u32x4*)(ag + i * astep + 256 * (c)); \
                           _Pragma("unroll") for (int i = 0; i < 2; ++i) s[4 + i] = *(const u32x4*)(bg + i * bstep + 256 * (c)); } while (0)
#define SQ_STORE(s, b) do { _Pragma("unroll") for (int i = 0; i < 4; ++i) *(LAS u32x4*)(sw + (b) * SQ_BUF + i * 16 * SQ_PITCH) = s[i]; \
                            _Pragma("unroll") for (int i = 0; i < 2; ++i) *(LAS u32x4*)(sw + (b) * SQ_BUF + SQ_A + i * 16 * SQ_PITCH) = s[4 + i]; } while (0)
#define SQ_COMPUTE(b, c) do { if (F::MID && (c) == cmid) { const float sm = f.mid_scale(row0 + 32 * rb + r32); _Pragma("unroll") for (int i = 0; i < 16; ++i) acc[i] *= sm; } \
        _Pragma("unroll") for (int j = 0; j < 4; ++j) { const bf16x8 a = *(const LAS bf16x8*)(ar + (b) * SQ_BUF + 32 * j); const bf16x8 w = *(const LAS bf16x8*)(br + (b) * SQ_BUF + 32 * j); \
            acc = __builtin_amdgcn_mfma_f32_32x32x16_bf16(w, a, acc, 0, 0, 0); } } while (0)
        SQ_LOAD(s0, 0);
        if (nsc > 1) SQ_LOAD(s1, 1);
        SQ_STORE(s0, 0);
        if (nsc > 2) SQ_LOAD(s0, 2);
        SQ_BAR();
        for (int c = 0; c < nsc; c += 2) {
            SQ_COMPUTE(0, c);
            if (c + 1 < nsc) { SQ_STORE(s1, 1); if (c + 3 < nsc) SQ_LOAD(s1, c + 3); }
            SQ_BAR();
            if (c + 1 >= nsc) break;
            SQ_COMPUTE(1, c + 1);
            if (c + 2 < nsc) { SQ_STORE(s0, 0); if (c + 4 < nsc) SQ_LOAD(s0, c + 4); }
            SQ_BAR();
        }
#undef SQ_LOAD
#undef SQ_STORE
#undef SQ_COMPUTE
        LAS float* P = (LAS float*)lds;
#pragma unroll
        for (int gq = 0; gq < 4; ++gq) *(LAS f32x4*)(P + ((kq * 64 + 32 * rb + r32) * SQ_PP + 8 * gq + 4 * h2)) = (f32x4){acc[4 * gq], acc[4 * gq + 1], acc[4 * gq + 2], acc[4 * gq + 3]};
        __syncthreads();
        {
            const LAS float* pr = P + er * SQ_PP + 4 * cq;
            const f32x4 v = (*(const LAS f32x4*)pr + *(const LAS f32x4*)(pr + 64 * SQ_PP)) + (*(const LAS f32x4*)(pr + 128 * SQ_PP) + *(const LAS f32x4*)(pr + 192 * SQ_PP));
            float ss = f.apply(rs, grow, nb0 + 4 * cq, v);
            if (F::STATS) { ss += __shfl_xor(ss, 1); ss += __shfl_xor(ss, 2); ss += __shfl_xor(ss, 4); if (cq == 0) f.st[(size_t)grow * SS + tc] = ss; }
        }
        __syncthreads();
    }
}


__device__ __forceinline__ Ctx ctx_from_kernarg() {
    Ctx c{};
#if defined(__HIP_DEVICE_COMPILE__)
    typedef const __attribute__((address_space(4))) unsigned long long* kptr_t;
    kptr_t kp = (kptr_t)__builtin_amdgcn_kernarg_segment_ptr(); asm volatile("" : "+s"(kp));
#pragma unroll
    for (int i = 0; i < 34; ++i) c.in[i] = (const float*)(GAS const float*)kp[i];
    c.out = (float*)(GAS float*)kp[34]; c.ws = (unsigned char*)(GAS unsigned char*)kp[35];
#endif
    return c;
}

constexpr int CW_BAR = 4096;
constexpr int LDS_BYTES = 155648;
constexpr int RED_OFF = 147456;
constexpr int MISC_OFF = 153600;
constexpr int MTAB_OFF = 151552;
__global__ __launch_bounds__(512, 2) void mega(Ctx c0) {
    extern __shared__ __attribute__((aligned(16))) unsigned char lds_raw[];
    LAS unsigned char* lds = (LAS unsigned char*)lds_raw; LAS float* red = (LAS float*)(lds + RED_OFF);
    const int G0 = gridDim.x, bx0 = blockIdx.x, wave0 = __builtin_amdgcn_readfirstlane(threadIdx.x >> 6);
#define LANE_ID() ({ int _l; asm volatile("v_mbcnt_lo_u32_b32 %0, -1, 0\n\tv_mbcnt_hi_u32_b32 %0, -1, %0" : "=v"(_l)); _l; })
    volatile LAS unsigned* misc = (volatile LAS unsigned*)(lds + MISC_OFF);
    if (threadIdx.x < 64) misc[threadIdx.x] = 0u;
    __syncthreads();
    (void)xcd_barrier_post((unsigned*)(c0.ws + WS_CTL) + CW_BAR, misc + 8);
#define GRID_SYNC() do { GAS unsigned char* _w = (GAS unsigned char*)ctx_from_kernarg().ws; XcdBarrier _b; _b.bar = (unsigned*)((unsigned char*)_w + WS_CTL) + CW_BAR; _b.x = xb_xcc_id(); _b.st = misc + 8; xcd_barrier(_b); } while (0)
#define PHASE_CTX int bx = bx0, G = G0; asm volatile("" : "+s"(bx), "+s"(G)); const int lane = LANE_ID(), wave = wave0, tid = wave * 64 + lane, gw = bx * 8 + wave, ngw = G * 8; (void)tid; (void)gw; (void)ngw; \
    Ctx c = ctx_from_kernarg();     \
    const Lw w = layer_w(c, l); (void)w; \
    bf16* xb = (bf16*)(c.ws + WS_XB); float* hf = (float*)(c.ws + WS_HF); bf16* hb = (bf16*)(c.ws + WS_HB); bf16* pp = (bf16*)(c.ws + WS_PP); bf16* pb = (bf16*)(c.ws + WS_PB) + (size_t)l * MT * PLE; \
    bf16* qb = (bf16*)(c.ws + WS_QB); bf16* vb = (bf16*)(c.ws + WS_VB); bf16* ub = (bf16*)(c.ws + WS_UB); bf16* gs = (bf16*)(c.ws + WS_GS); bf16* mg = (bf16*)(c.ws + WS_MG); bf16* act = (bf16*)(c.ws + WS_ACT); \
    (void)xb; (void)hf; (void)hb; (void)pp; (void)pb; (void)qb; (void)vb; (void)ub; (void)gs; (void)mg; (void)act;
    { const int lane = LANE_ID(), wave = wave0; p0_prologue(c0, lds, bx0 * 8 + wave, G0 * 8, wave, lane); }
    GRID_SYNC();
#define STAG(it) (((it) == 0) == ((bx0 & 1) == 0))
    for (int l = 0; l < NL; ++l) {
        const int nsxP = l == 0 ? 1 : D / 256, nsxS = l == 0 ? 1 : D / 32;
        { PHASE_CTX EpiIn e{stat_ptr(c, ST_X), nsxP, nsxS, nullptr, qb, vb, ub, c.out + O_KP + (size_t)l * MP * AW, c.out + O_KS + (size_t)l * MS * AW, c.out + O_VP + (size_t)l * MP * AW, c.out + O_VS + (size_t)l * MS * AW, (bf16*)(c.ws + WS_KB), c.in[12] + l * HD, c.in[13] + l * HD};
          EpiF ef{stat_ptr(c, ST_X), nsxP, nsxS, nullptr, c.in[11] + l * NH, c.out + O_LFP + (size_t)l * MP * NH, c.out + O_LFS + (size_t)l * MS * NH};
          const int ord = (bx0 & 3) == 0 ? 0x24 : (bx0 & 3) == 1 ? 0x12 : (bx0 & 3) == 2 ? 0x18 : 0x09;
          for (int it = 0; it < 3; ++it) {
              const int part = (ord >> (2 * it)) & 3;
              if (part == 0) { GArgs g{xb, D, w.win, D, D, MP, 4, 4096 / 32, 0}; sq2_gemm(lds, g, e, G, bx, tid); }
              else if (part == 1) { GArgs gf{xb, D, w.wf, D, D, 0, MP / 64, 1, 0}; sq2_gemm(lds, gf, ef, G, G - 1 - bx, tid); }
              else { pg8::Gemm gg{xb, w.win, MP, 4096, D}; pg8::StaticOrder S; S.init(MP, 4096, G, bx); pg8::gemm_phase<false>(lds, red, gg, S, e, tid); }
          } }
        GRID_SYNC();
        { PHASE_CTX ssm::ssm_phase(c, l, lds, G, bx, tid); }
        { PHASE_CTX qknorm_rows(c, l, gw, ngw, lane); flogit_rows(c, l, ngw - 1 - gw, ngw, lane, nsxS); }
        GRID_SYNC();
        for (int it = 0; it < 2; ++it) {
        if (STAG(it)) { PHASE_CTX att::attn_phase(c, l, lds, G, bx, tid); __syncthreads(); }
        else { PHASE_CTX EpiGlu e{stat_ptr(c, ST_S), c.in[23] + l * SW, gs, mg};
          GArgs g{gs, SW, w.wglu, SW, SW, MP, 4, SW / 32, 0}; sq2_gemm(lds, g, e, G, bx, tid);
          pg8::Gemm gg{gs, w.wglu, MP, SW, SW}; pg8::StaticOrder S; S.init(MP, SW, G, bx); pg8::gemm_phase<false>(lds, red, gg, S, e, tid); __syncthreads(); } }
        GRID_SYNC();
        { PHASE_CTX LAS float* mtab = (LAS float*)(lds + MTAB_OFF);
          EpiOut e{stat_ptr(c, ST_H), stat_ptr(c, ST_A), stat_ptr(c, ST_S), SW / 256, SW / 32, c.in[0], c.in[1], (const bf16*)xb, hb, mtab};
          for (int it = 0; it < 2; ++it) {
          if (STAG(it)) { GArgs g{mg, D, w.wout, D, D, MP, 4, D / 32, AW}; sq2_gemm(lds, g, e, G, bx, tid); continue; }
          pg8::Gemm gg{mg, w.wout, MP, D, D}; pg8::StaticOrder S; S.init(MP, D, G, bx);
          { int t2 = tid; asm volatile("" : "+v"(t2)); for (int i = 0; i < 2; ++i) { pg8::Unit u; if (S.next(i, u) && (t2 >> 8) == i) mtab[t2] = e.mid_scale(u.pm * 256 + (t2 & 255)); } }
          __syncthreads();
          pg8::gemm_phase<false>(lds, red, gg, S, e, tid); } }
        GRID_SYNC();
        for (int it = 0; it < 2; ++it) {
        if (STAG(it)) { PHASE_CTX EpiGU e{nullptr, stat_ptr(c, ST_H), D / 256, D / 32, act};
          GArgs g{hb, D, w.wgu, D, D, MP, 1, DFF / 32, 0}; sk_gemm<2, true>(lds, g, e, G, bx, tid);
          pg8::Gemm gg{hb, w.wgu, MP, NGU, D}; pg8::StaticOrder S; S.init(MP, NGU, G, bx); pg8::gemm_phase<true>(lds, red, gg, S, e, tid); }
        else { PHASE_CTX
          EpiPP e{nullptr, pp};
          GArgs g{pb, PLE, w.wpp, PLE, PLE, MP, 1, D / 32, 0}; sk_gemm<1, false>(lds, g, e, G, (bx + G - 176) % G, tid);
          pg8::Gemm gg{pb, w.wpp, MP, D, PLE}; pg8::StaticOrder S; S.init(MP, D, G, bx); pg8::gemm_phase<false>(lds, red, gg, S, e, tid); } }
        GRID_SYNC();
        { PHASE_CTX EpiDown e{stat_ptr(c, ST_H2), hb};
          for (int it = 0; it < 2; ++it) {
              if (STAG(it)) { GArgs g{act, DFF, w.wdown, DFF, DFF, MP, 4, D / 32, 0}; sq2_gemm(lds, g, e, G, bx, tid); }
              else { pg8::Gemm gg{act, w.wdown, MP, D, DFF}; pg8::StaticOrder S; S.init(MP, D, G, bx); pg8::gemm_phase<false>(lds, red, gg, S, e, tid); } } }
        GRID_SYNC();
        { PHASE_CTX EpiPle e{stat_ptr(c, ST_X), stat_ptr(c, ST_H2), D / 256, D / 32, pp, hb, xb, c.out + O_YP, c.out + O_YS, l == NL - 1 ? 1 : 0};
          for (int it = 0; it < 2; ++it) {
              if (STAG(it)) { GArgs g{hb, D, w.wple, D, D, MP, 4, D / 32, 0}; sq2_gemm(lds, g, e, G, bx, tid); }
              else { pg8::Gemm gg{hb, w.wple, MP, D, D}; pg8::StaticOrder S; S.init(MP, D, G, bx); pg8::gemm_phase<false>(lds, red, gg, S, e, tid); } } }
        if (l + 1 < NL) GRID_SYNC();
    }
}

extern "C" void kernel_launch(void* const* d_in, const int* in_sizes, int n_in, void* d_out, int out_size, void* d_ws, size_t ws_size, hipStream_t stream) {
    if (n_in != 34 || (size_t)out_size != O_END || ws_size < WS_END) { fprintf(stderr, "kernel_launch: unexpected sizes n_in %d out %d (want %zu) ws %zu (want %zu)\n", n_in, out_size, (size_t)O_END, ws_size, (size_t)WS_END); return; }
    static int grid = 0;
    if (grid == 0) {
        int dev = 0, cus = 0, per_cu = 0;
        if (hipGetDevice(&dev) != hipSuccess || hipDeviceGetAttribute(&cus, hipDeviceAttributeMultiprocessorCount, dev) != hipSuccess) { fprintf(stderr, "kernel_launch: device query failed\n"); grid = -1; return; }
        if (hipFuncSetAttribute((const void*)mega, hipFuncAttributeMaxDynamicSharedMemorySize, LDS_BYTES) != hipSuccess) { fprintf(stderr, "kernel_launch: hipFuncSetAttribute failed\n"); grid = -1; return; }
        if (hipOccupancyMaxActiveBlocksPerMultiprocessor(&per_cu, (const void*)mega, 512, LDS_BYTES) != hipSuccess || per_cu < 1) { fprintf(stderr, "kernel_launch: occupancy query says %d blocks per CU\n", per_cu); (void)hipGetLastError(); per_cu = 1; }
        grid = cus;
    }
    if (grid < 0) return;
    (void)hipMemsetAsync((char*)d_ws + WS_CTL, 0, CTL_BYTES, stream);
    Ctx c{}; for (int i = 0; i < 34; ++i) c.in[i] = (const float*)d_in[i]; c.out = (float*)d_out; c.ws = (unsigned char*)d_ws;
    hipLaunchKernelGGL(mega, dim3(grid), dim3(512), LDS_BYTES, stream, c);
}
```

```cpp
#include <hip/hip_runtime.h>
#include <cstdio>
#include <cstdint>

#define LAS __attribute__((address_space(3)))
#define GAS __attribute__((address_space(1)))
typedef unsigned short bf16;
typedef short bf16x8 __attribute__((ext_vector_type(8)));
typedef short s16x4 __attribute__((ext_vector_type(4)));
typedef float f32x4 __attribute__((ext_vector_type(4)));
typedef float f32x2 __attribute__((ext_vector_type(2)));
typedef float f32x16 __attribute__((ext_vector_type(16)));
typedef unsigned u32x4 __attribute__((ext_vector_type(4)));
typedef unsigned u32x2 __attribute__((ext_vector_type(2)));

constexpr int D = 2048, MP = 16384, MS = 256, MT = MP + MS, NH = 8, HD = 128, AW = 1024, SW = 1024, NG = 64, NP = 64, DFF = 5632, PLE = 256, INC = 4104;
constexpr int NL = 2, PAST = 2048, SEQ = 2048, DSEQ = 16, NBAT = 8, DBAT = 16, NGU = 2 * DFF;
constexpr float EPS = 1e-6f;
constexpr float QSCALE = 0.08838834764831845f * 1.4426950408889634f;
constexpr float LOG2E = 1.4426950408889634f;
constexpr int SS = 64;

constexpr size_t O_YP = 0, O_YS = O_YP + (size_t)MP * D, O_KP = O_YS + (size_t)MS * D, O_VP = O_KP + (size_t)NL * MP * AW, O_LFP = O_VP + (size_t)NL * MP * AW,
                 O_SRP = O_LFP + (size_t)NL * MP * NH, O_SIP = O_SRP + (size_t)NL * NBAT * NG * NP, O_KS = O_SIP + (size_t)NL * NBAT * NG * NP, O_VS = O_KS + (size_t)NL * MS * AW,
                 O_LFS = O_VS + (size_t)NL * MS * AW, O_SRS = O_LFS + (size_t)NL * MS * NH, O_SIS = O_SRS + (size_t)NL * DBAT * NG * NP, O_END = O_SIS + (size_t)NL * DBAT * NG * NP;

constexpr size_t al256(size_t x) { return (x + 255) & ~(size_t)255; }
constexpr size_t WS_CTL = 0, CTL_BYTES = 1 << 20;
constexpr size_t W_IN = 0, W_F = W_IN + (size_t)4096 * D * 2, W_GLU = W_F + (size_t)32 * D * 2, W_OUT = W_GLU + (size_t)SW * SW * 2, W_GU = W_OUT + (size_t)D * D * 2,
                 W_DOWN = W_GU + (size_t)NGU * D * 2, W_PLE = W_DOWN + (size_t)D * DFF * 2, W_PP = W_PLE + (size_t)D * D * 2, W_ABR = W_PP + (size_t)D * PLE * 2,
                 W_ABI = W_ABR + (size_t)NG * NP * 4, W_BCAT = W_ABI + (size_t)NG * NP * 4, W_CCAT = W_BCAT + (size_t)NG * 128 * 16 * 2, W_LAYER = al256(W_CCAT + (size_t)NG * 16 * 128 * 2);
constexpr size_t WS_W = CTL_BYTES;
constexpr size_t WS_XB = WS_W + NL * W_LAYER;
constexpr size_t WS_HF = WS_XB + (size_t)MT * D * 2;
constexpr size_t WS_HB = WS_HF + (size_t)MT * D * 4;
constexpr size_t WS_PB = WS_HB + (size_t)MT * D * 2;
constexpr size_t WS_PP = WS_PB + (size_t)NL * MT * PLE * 2;
constexpr size_t WS_ST = WS_PP + (size_t)MT * D * 2;
constexpr size_t ST_BYTES = (size_t)MT * SS * 4;
constexpr size_t WS_CUM = WS_ST + 5 * ST_BYTES;
constexpr size_t WS_OV = al256(WS_CUM + (size_t)MP * NH * 4 + (size_t)DBAT * (PAST + DSEQ) * NH * 4);
constexpr size_t WS_QB = WS_OV, WS_KB = WS_QB + (size_t)MT * AW * 2, WS_VB = WS_KB + (size_t)MT * AW * 2, WS_UB = WS_VB + (size_t)MT * AW * 2,
                 WS_GS = WS_UB + (size_t)MT * SW * 2, WS_MG = WS_GS + (size_t)MT * SW * 2, WS_OV_END1 = WS_MG + (size_t)MT * D * 2;
constexpr size_t WS_ACT = WS_OV, WS_OV_END2 = WS_ACT + (size_t)MT * DFF * 2;
constexpr size_t WS_END = WS_OV_END1 > WS_OV_END2 ? WS_OV_END1 : WS_OV_END2;

struct Ctx {
    const float* in[34];
    float* out;
    unsigned char* ws;
};

typedef __bf16 bf16x2_t __attribute__((ext_vector_type(2)));
__device__ __forceinline__ unsigned cvtpk(float lo, float hi) { const f32x2 v = {lo, hi}; const bf16x2_t b = __builtin_convertvector(v, bf16x2_t); return __builtin_bit_cast(unsigned, b); }
__device__ __forceinline__ float bf2f(unsigned short b) { return __uint_as_float(((unsigned)b) << 16); }
__device__ __forceinline__ float bflo(unsigned w) { return __uint_as_float(w << 16); }
__device__ __forceinline__ float bfhi(unsigned w) { return __uint_as_float(w & 0xffff0000u); }
__device__ __forceinline__ float wave_sum(float v) {
#pragma unroll
    for (int o = 1; o < 64; o <<= 1) v += __shfl_xor(v, o);
    return v;
}
__device__ __forceinline__ float wave_max(float v) {
#pragma unroll
    for (int o = 1; o < 64; o <<= 1) v = fmaxf(v, __shfl_xor(v, o));
    return v;
}
__device__ __forceinline__ float sigmoidf_(float x) { return __builtin_amdgcn_rcpf(1.0f + __builtin_amdgcn_exp2f(x * -1.4426950408889634f)); }
__device__ __forceinline__ float log_sigmoid_(float z) { return fminf(z, 0.f) - log1pf(expf(-fabsf(z))); }
__device__ __forceinline__ float gelu_tanh_(float y) { const float t = 0.7978845608028654f * (y + 0.044715f * y * y * y); return y * sigmoidf_(2.0f * t); }

struct Lw {
    const bf16 *win, *wf, *wglu, *wout, *wgu, *wdown, *wple, *wpp, *bcat, *ccat; const float *abr, *abi;
};
__device__ __forceinline__ Lw layer_w(const Ctx& c, int l) {
    unsigned char* b = c.ws + WS_W + (size_t)l * W_LAYER; Lw w;
    w.win = (const bf16*)(b + W_IN); w.wf = (const bf16*)(b + W_F); w.wglu = (const bf16*)(b + W_GLU); w.wout = (const bf16*)(b + W_OUT); w.wgu = (const bf16*)(b + W_GU);
    w.wdown = (const bf16*)(b + W_DOWN); w.wple = (const bf16*)(b + W_PLE); w.wpp = (const bf16*)(b + W_PP); w.abr = (const float*)(b + W_ABR); w.abi = (const float*)(b + W_ABI);
    w.bcat = (const bf16*)(b + W_BCAT); w.ccat = (const bf16*)(b + W_CCAT); return w;
}
__device__ __forceinline__ float* stat_ptr(const Ctx& c, int which) { return (float*)(c.ws + WS_ST + (size_t)which * ST_BYTES); }
enum { ST_X = 0, ST_A = 1, ST_S = 2, ST_H = 3, ST_H2 = 4 };
__device__ __forceinline__ float row_rs(const float* st, int row, int ns, float invn) {
    const float* p = st + (size_t)row * SS; float s = 0.f;
    if (ns == 1) s = p[0];
    else for (int i = 0; i < ns; i += 4) { const f32x4 v = *(const f32x4*)(p + i); s += (v.x + v.y) + (v.z + v.w); }
    return rsqrtf(s * invn + EPS);
}

struct TrItem { const float* W; int ldw, src_col0; const float* gain; bf16* WT; int K, dst_row0, k0, nvalid; };
__device__ __forceinline__ void tr_load(const TrItem& t, f32x4 (&v)[8], int lane) {
    const int kr = lane >> 3, n4 = (lane & 7) * 4;
#pragma unroll
    for (int i = 0; i < 8; ++i) v[i] = (n4 < t.nvalid) ? *(const f32x4*)(t.W + (size_t)(t.k0 + 8 * i + kr) * t.ldw + t.src_col0 + n4) : (f32x4){0.f, 0.f, 0.f, 0.f};
}
__device__ __forceinline__ void tr_store(const TrItem& t, const f32x4 (&v)[8], LAS float* scr, int lane) {
    const int kr = lane >> 3, n4 = (lane & 7) * 4;
#pragma unroll
    for (int i = 0; i < 8; ++i) { const int kk = 8 * i + kr; const float gn = t.gain ? t.gain[t.k0 + kk] : 1.0f; LAS float* d = scr + kk * 33 + n4;
        d[0] = v[i].x * gn; d[1] = v[i].y * gn; d[2] = v[i].z * gn; d[3] = v[i].w * gn; }
    asm volatile("s_waitcnt lgkmcnt(0)" ::: "memory");
    const int c = lane & 7;
#pragma unroll
    for (int j = 0; j < 4; ++j) { const int n = (lane >> 3) + 8 * j; const LAS float* s = scr + (8 * c) * 33 + n;
        u32x4 o; o.x = cvtpk(s[0 * 33], s[1 * 33]); o.y = cvtpk(s[2 * 33], s[3 * 33]); o.z = cvtpk(s[4 * 33], s[5 * 33]); o.w = cvtpk(s[6 * 33], s[7 * 33]);
        *(u32x4*)(t.WT + (size_t)(t.dst_row0 + n) * t.K + t.k0 + 8 * c) = o; }
    asm volatile("s_waitcnt lgkmcnt(0)" ::: "memory");
}
constexpr int I_IN = 32 * 128, I_GU = 32 * 352, I_OUT = 32 * 64, I_GLU = 16 * 32, I_DOWN = 88 * 64, I_PLE = 32 * 64, I_PP = 4 * 64, I_F = 32;
constexpr int I_LAYER = I_IN + I_GU + I_OUT + I_GLU + I_DOWN + I_PLE + I_PP + I_F;
__device__ __forceinline__ TrItem tr_item_of(const Ctx& c, int it) {
    const int l = it / I_LAYER; int r = it % I_LAYER; unsigned char* wb = c.ws + WS_W + (size_t)l * W_LAYER; TrItem t;
    if (r < I_IN) { const int kb = r / 128, nb = r % 128, n0 = 32 * nb;
        t = TrItem{c.in[10] + (size_t)l * D * INC, INC, n0 + (n0 >= 3072 ? 8 : 0), c.in[9] + l * D, (bf16*)(wb + W_IN), D, n0, 64 * kb, 32}; return t; } r -= I_IN;
    if (r < I_GU) { const int kb = r / 352, nb = r % 352, n0 = 32 * nb, pn = n0 >> 8, half = (n0 >> 7) & 1, j0 = n0 & 127;
        t = TrItem{(half ? c.in[29] : c.in[28]) + (size_t)l * D * DFF, DFF, 128 * pn + j0, c.in[27] + l * D, (bf16*)(wb + W_GU), D, n0, 64 * kb, 32}; return t; } r -= I_GU;
    if (r < I_OUT) { const int kb = r / 64, nb = r % 64, k0 = 64 * kb;
        t = TrItem{c.in[26] + (size_t)l * D * D, D, 32 * nb, (k0 < AW) ? (c.in[24] + l * AW) : (c.in[25] + l * SW - AW), (bf16*)(wb + W_OUT), D, 32 * nb, k0, 32}; return t; } r -= I_OUT;
    if (r < I_GLU) { const int kb = r / 32, nb = r % 32;
        t = TrItem{c.in[22] + (size_t)l * SW * SW, SW, 32 * nb, nullptr, (bf16*)(wb + W_GLU), SW, 32 * nb, 64 * kb, 32}; return t; } r -= I_GLU;
    if (r < I_DOWN) { const int kb = r / 64, nb = r % 64;
        t = TrItem{c.in[30] + (size_t)l * DFF * D, D, 32 * nb, nullptr, (bf16*)(wb + W_DOWN), DFF, 32 * nb, 64 * kb, 32}; return t; } r -= I_DOWN;
    if (r < I_PLE) { const int kb = r / 64, nb = r % 64;
        t = TrItem{c.in[32] + (size_t)l * D * D, D, 32 * nb, c.in[31] + l * D, (bf16*)(wb + W_PLE), D, 32 * nb, 64 * kb, 32}; return t; } r -= I_PLE;
    if (r < I_PP) { const int kb = r / 64, nb = r % 64;
        t = TrItem{c.in[33] + (size_t)l * PLE * D, D, 32 * nb, nullptr, (bf16*)(wb + W_PP), PLE, 32 * nb, 64 * kb, 32}; return t; } r -= I_PP;
    t = TrItem{c.in[10] + (size_t)l * D * INC, INC, 3072, c.in[9] + l * D, (bf16*)(wb + W_F), D, 0, 64 * r, 8}; return t;
}

__device__ __forceinline__ void p0_prologue(const Ctx& c, LAS unsigned char* lds, int gw, int ngw, int wave, int lane) {
    LAS float* scr = (LAS float*)(lds + wave * 8448);
    { f32x4 va[8], vb_[8]; int it = gw;
      TrItem ta = tr_item_of(c, it < NL * I_LAYER ? it : 0), tb = ta;
      if (it < NL * I_LAYER) tr_load(ta, va, lane);
      while (it < NL * I_LAYER) {
          const int i1 = it + ngw; if (i1 < NL * I_LAYER) { tb = tr_item_of(c, i1); tr_load(tb, vb_, lane); }
          tr_store(ta, va, scr, lane);
          if (i1 >= NL * I_LAYER) break;
          const int i2 = i1 + ngw; if (i2 < NL * I_LAYER) { ta = tr_item_of(c, i2); tr_load(ta, va, lane); }
          tr_store(tb, vb_, scr, lane);
          it = i2;
      } }
    for (int i = gw * 64 + lane; i < NL * NG * NP; i += ngw * 64) {
        const int l = i / (NG * NP), g = (i / NP) % NG, p = i % NP; unsigned char* wb = c.ws + WS_W + (size_t)l * W_LAYER;
        const float ar = c.in[14][i], ai = c.in[15][i], dt = expf(c.in[16][l * NG + g]);
        const float mag = expf(ar * dt), ang = ai * dt, abr = mag * cosf(ang), abi = mag * sinf(ang), den = ar * ar + ai * ai, nr = abr - 1.0f, ni = abi;
        const float cr = (nr * ar + ni * ai) / den, ci = (ni * ar - nr * ai) / den;
        ((float*)(wb + W_ABR))[g * NP + p] = abr; ((float*)(wb + W_ABI))[g * NP + p] = abi;
        const float* br = c.in[17] + (size_t)i * 16; const float* bi = c.in[18] + (size_t)i * 16;
        bf16* bc = (bf16*)(wb + W_BCAT) + (size_t)g * 128 * 16;
        for (int ch = 0; ch < 16; ch += 2) {
            const float r0 = cr * br[ch] - ci * bi[ch], r1 = cr * br[ch + 1] - ci * bi[ch + 1], i0 = cr * bi[ch] + ci * br[ch], i1 = cr * bi[ch + 1] + ci * br[ch + 1];
            *(unsigned*)(bc + p * 16 + ch) = cvtpk(r0, r1); *(unsigned*)(bc + (64 + p) * 16 + ch) = cvtpk(i0, i1); }
        bf16* cc = (bf16*)(wb + W_CCAT) + (size_t)g * 16 * 128;
        const float* cre = c.in[19] + ((size_t)l * NG + g) * 16 * NP; const float* cim = c.in[20] + ((size_t)l * NG + g) * 16 * NP;
        for (int ch = 0; ch < 16; ++ch) { cc[ch * 128 + p] = (bf16)(cvtpk(cre[ch * NP + p], 0.f) & 0xffff); cc[ch * 128 + 64 + p] = (bf16)(cvtpk(-cim[ch * NP + p], 0.f) & 0xffff); }
    }
    bf16* xb = (bf16*)(c.ws + WS_XB); float* stx = stat_ptr(c, ST_X);
    for (int row0 = 2 * gw; row0 < MT; row0 += 2 * ngw) {
        f32x4 v[2][8];
#pragma unroll
        for (int q = 0; q < 2; ++q) { const int row = row0 + q; const float* xr = row < MP ? c.in[0] + (size_t)row * D : c.in[1] + (size_t)(row - MP) * D;
#pragma unroll
            for (int j = 0; j < 8; ++j) v[q][j] = *(const f32x4*)(xr + j * 256 + lane * 4); }
#pragma unroll
        for (int q = 0; q < 2; ++q) { const int row = row0 + q; float s = 0.f;
#pragma unroll
            for (int j = 0; j < 8; ++j) { const f32x4 w = v[q][j]; s += (w.x * w.x + w.y * w.y) + (w.z * w.z + w.w * w.w);
                u32x2 o; o.x = cvtpk(w.x, w.y); o.y = cvtpk(w.z, w.w); *(u32x2*)(xb + (size_t)row * D + j * 256 + lane * 4) = o; }
            s = wave_sum(s); if (lane == 0) stx[(size_t)row * SS] = s; }
    }
    bf16* pb = (bf16*)(c.ws + WS_PB);
    for (int i0 = 8 * gw; i0 < NL * MT; i0 += 8 * ngw) {
        f32x4 v[8];
#pragma unroll
        for (int q = 0; q < 8; ++q) { const int i = i0 + q, l = i / MT, row = i % MT;
            const float* pr = row < MP ? c.in[7] + ((size_t)l * MP + row) * PLE : c.in[8] + ((size_t)l * MS + (row - MP)) * PLE; v[q] = *(const f32x4*)(pr + lane * 4); }
#pragma unroll
        for (int q = 0; q < 8; ++q) { u32x2 o; o.x = cvtpk(v[q].x, v[q].y); o.y = cvtpk(v[q].z, v[q].w); *(u32x2*)(pb + (size_t)(i0 + q) * PLE + lane * 4) = o; } }
}

constexpr size_t UB_S_OFF = (size_t)NBAT * NG * SEQ * 16;
__device__ __forceinline__ void st_bf4(bf16* p, f32x4 v) { u32x2 o; o.x = cvtpk(v.x, v.y); o.y = cvtpk(v.z, v.w); *(u32x2*)p = o; }
__device__ __forceinline__ f32x4 ld_bf4(const bf16* p) { const u32x2 w = *(const u32x2*)p; return (f32x4){bflo(w.x), bfhi(w.x), bflo(w.y), bfhi(w.y)}; }
__device__ __forceinline__ float sumsq4(f32x4 v) { return (v.x * v.x + v.y * v.y) + (v.z * v.z + v.w * v.w); }

struct EpiIn {
    static constexpr bool MID = false, STATS = false, HAS_RS = true, QKN = true;
    const float* stx; int nsP, nsS; float* st;
    bf16 *qb, *vb, *ub; float *kP, *kS, *vP, *vS; bf16* kb; const float *gq, *gk;
    __device__ __forceinline__ float row_begin(int row) const { return row_rs(stx, row, row < MP ? nsP : nsS, 1.0f / D); }
    __device__ __forceinline__ float mid_scale(int) const { return 1.f; }
    __device__ __forceinline__ float apply(float rs, int row, int col, f32x4 v) const {
        v = v * rs;
        if (col < 1024) { st_bf4(qb + (size_t)row * AW + col, v); }
        else if (col < 2048) { float* k = row < MP ? kP + (size_t)row * AW : kS + (size_t)(row - MP) * AW; *(f32x4*)(k + (col - 1024)) = v; }
        else if (col < 3072) { float* vo = row < MP ? vP + (size_t)row * AW : vS + (size_t)(row - MP) * AW; *(f32x4*)(vo + (col - 2048)) = v; st_bf4(vb + (size_t)row * AW + (col - 2048), v); }
        else { const int c = col - 3072, g = c >> 4, ch = c & 15; const int r = row - MP;
            const size_t idx = row < MP ? (((size_t)(row >> 11) * NG + g) * SEQ + (row & 2047)) * 16 + ch : UB_S_OFF + (((size_t)(r >> 4) * NG + g) * DSEQ + (r & 15)) * 16 + ch;
            st_bf4(ub + idx, v); }
        return 0.f;
    }
};
struct EpiF {
    static constexpr bool MID = false, STATS = false, HAS_RS = true, QKN = false;
    const float* stx; int nsP, nsS; float* st;
    const float* bf; float *lfP, *lfS;
    __device__ __forceinline__ float row_begin(int row) const { return row_rs(stx, row, row < MP ? nsP : nsS, 1.0f / D); }
    __device__ __forceinline__ float mid_scale(int) const { return 1.f; }
    __device__ __forceinline__ float apply(float rs, int row, int col, f32x4 v) const {
        if (col < 8) { f32x4 o;
#pragma unroll
            for (int e = 0; e < 4; ++e) o[e] = log_sigmoid_(rs * v[e] + bf[col + e]);
            float* p = row < MP ? lfP + (size_t)row * NH : lfS + (size_t)(row - MP) * NH; *(f32x4*)(p + col) = o; }
        return 0.f;
    }
};
struct EpiGlu {
    static constexpr bool MID = false, STATS = true, HAS_RS = false, QKN = false;
    float* st; const float* bglu; const bf16* gs; bf16* mg;
    __device__ __forceinline__ float row_begin(int) const { return 1.f; }
    __device__ __forceinline__ float mid_scale(int) const { return 1.f; }
    __device__ __forceinline__ float apply(float, int row, int col, f32x4 v) const {
        const f32x4 b = *(const f32x4*)(bglu + col); const f32x4 g = ld_bf4(gs + (size_t)row * SW + col); f32x4 s;
#pragma unroll
        for (int e = 0; e < 4; ++e) s[e] = g[e] * sigmoidf_(v[e] + b[e]);
        st_bf4(mg + (size_t)row * D + AW + col, s); return sumsq4(s);
    }
};
struct EpiOut {
    static constexpr bool MID = true, STATS = true, HAS_RS = true, QKN = false;
    float* st; const float *sta, *sts; int nsS_P, nsS_S; const float *xinP, *xinS; const bf16* xinB; bf16* hb; const LAS float* mid_tab;
    __device__ __forceinline__ float r_s(int row) const { return row_rs(sts, row, row < MP ? nsS_P : nsS_S, 1.0f / SW); }
    __device__ __forceinline__ float row_begin(int row) const { return r_s(row); }
    __device__ __forceinline__ float mid_scale(int row) const { return row_rs(sta, row, NH, 1.0f / AW) / r_s(row); }
    __device__ __forceinline__ float apply(float rs, int row, int col, f32x4 v) const {
        f32x4 x;
        if (xinB) x = ld_bf4(xinB + (size_t)row * D + col); else { const float* xin = row < MP ? xinP + (size_t)row * D : xinS + (size_t)(row - MP) * D; x = *(const f32x4*)(xin + col); }
        const f32x4 h = x + v * rs;
        st_bf4(hb + (size_t)row * D + col, h); return sumsq4(h);
    }
};
struct EpiGU {
    static constexpr bool MID = false, STATS = false, HAS_RS = true, QKN = false;
    float* st; const float* sth; int nsP, nsS; bf16* act;
    __device__ __forceinline__ float row_begin(int row) const { return row_rs(sth, row, row < MP ? nsP : nsS, 1.0f / D); }
    __device__ __forceinline__ float mid_scale(int) const { return 1.f; }
    __device__ __forceinline__ float apply2(float rs, int row, int col, f32x4 vg, f32x4 vu) const {
        f32x4 a;
#pragma unroll
        for (int e = 0; e < 4; ++e) { const float g = rs * vg[e], u = rs * vu[e]; a[e] = g * sigmoidf_(g) * u; }
        st_bf4(act + (size_t)row * DFF + col, a); return 0.f;
    }
};
struct EpiDown {
    static constexpr bool MID = false, STATS = true, HAS_RS = false, QKN = false;
    float* st; bf16* hb;
    __device__ __forceinline__ float row_begin(int) const { return 1.f; }
    __device__ __forceinline__ float mid_scale(int) const { return 1.f; }
    __device__ __forceinline__ float apply(float, int row, int col, f32x4 v) const {
        bf16* p = hb + (size_t)row * D + col; const f32x4 h = ld_bf4(p) + v; st_bf4(p, h); return sumsq4(h);
    }
};
struct EpiPP {
    static constexpr bool MID = false, STATS = false, HAS_RS = false, QKN = false;
    float* st; bf16* pp;
    __device__ __forceinline__ float row_begin(int) const { return 1.f; }
    __device__ __forceinline__ float mid_scale(int) const { return 1.f; }
    __device__ __forceinline__ float apply(float, int row, int col, f32x4 v) const { st_bf4(pp + (size_t)row * D + col, v); return 0.f; }
};
struct EpiPle {
    static constexpr bool MID = false, STATS = true, HAS_RS = true, QKN = false;
    float* st; const float* sth2; int nsP, nsS; const bf16* pp; const bf16* hb; bf16* xb; float *yP, *yS; int last;
    __device__ __forceinline__ float row_begin(int row) const { return row_rs(sth2, row, row < MP ? nsP : nsS, 1.0f / D); }
    __device__ __forceinline__ float mid_scale(int) const { return 1.f; }
    __device__ __forceinline__ float apply(float rs, int row, int col, f32x4 v) const {
        const f32x4 h = ld_bf4(hb + (size_t)row * D + col); const f32x4 q = ld_bf4(pp + (size_t)row * D + col); f32x4 o;
#pragma unroll
        for (int e = 0; e < 4; ++e) o[e] = h[e] + sigmoidf_(rs * v[e]) * q[e];
        if (last) { float* y = row < MP ? yP + (size_t)row * D : yS + (size_t)(row - MP) * D; *(f32x4*)(y + col) = o; return 0.f; }
        st_bf4(xb + (size_t)row * D + col, o); return sumsq4(o);
    }
};

struct GArgs { const bf16* A; int lda; const bf16* Bt; int ldb; int K; int r0; int nrt; int nct; int kmid; };
template <int NB, bool PAIR, class F>
__device__ __forceinline__ void dg_gemm(const GArgs& g, const F& f, int gw, int ngw, int lane) {
    asm volatile("" : "+v"(lane));
    const int r32 = lane & 31, h = lane >> 5, ntiles = g.nrt * g.nct, nks = g.K / 16;
    for (int t = gw; t < ntiles; t += ngw) {
        const int tr = t / g.nct, tc = t % g.nct, row = g.r0 + 32 * tr + r32;
        int nb0, nb1, colbase;
        if (PAIR) { nb0 = 256 * (tc >> 2) + 32 * (tc & 3); nb1 = nb0 + 128; colbase = 32 * tc; } else { nb0 = 32 * NB * tc; nb1 = nb0 + 32; colbase = nb0; }
        const bf16* ap = g.A + (size_t)row * g.lda + 8 * h;
        const bf16* bp0 = g.Bt + (size_t)(nb0 + r32) * g.ldb + 8 * h;
        const bf16* bp1 = g.Bt + (size_t)(nb1 + r32) * g.ldb + 8 * h;
        f32x16 acc0 = {}, acc1 = {};
        const int k1 = F::MID ? g.kmid / 16 : nks;
#pragma unroll 4
        for (int ks = 0; ks < k1; ++ks) {
            const bf16x8 a = *(const bf16x8*)(ap + 16 * ks); const bf16x8 b0 = *(const bf16x8*)(bp0 + 16 * ks);
            acc0 = __builtin_amdgcn_mfma_f32_32x32x16_bf16(b0, a, acc0, 0, 0, 0);
            if (NB == 2) { const bf16x8 b1 = *(const bf16x8*)(bp1 + 16 * ks); acc1 = __builtin_amdgcn_mfma_f32_32x32x16_bf16(b1, a, acc1, 0, 0, 0); }
        }
        if (F::MID) {
            const float sc = f.mid_scale(row);
#pragma unroll
            for (int i = 0; i < 16; ++i) { acc0[i] *= sc; acc1[i] *= sc; }
#pragma unroll 4
            for (int ks = k1; ks < nks; ++ks) {
                const bf16x8 a = *(const bf16x8*)(ap + 16 * ks); const bf16x8 b0 = *(const bf16x8*)(bp0 + 16 * ks);
                acc0 = __builtin_amdgcn_mfma_f32_32x32x16_bf16(b0, a, acc0, 0, 0, 0);
                if (NB == 2) { const bf16x8 b1 = *(const bf16x8*)(bp1 + 16 * ks); acc1 = __builtin_amdgcn_mfma_f32_32x32x16_bf16(b1, a, acc1, 0, 0, 0); }
            }
        }
        const float rs = f.row_begin(row); float ss = 0.f;
        if constexpr (PAIR) {
#pragma unroll
            for (int gq = 0; gq < 4; ++gq) ss += f.apply2(rs, row, colbase + 8 * gq + 4 * h, (f32x4){acc0[4 * gq], acc0[4 * gq + 1], acc0[4 * gq + 2], acc0[4 * gq + 3]}, (f32x4){acc1[4 * gq], acc1[4 * gq + 1], acc1[4 * gq + 2], acc1[4 * gq + 3]});
        } else {
#pragma unroll
            for (int gq = 0; gq < 4; ++gq) ss += f.apply(rs, row, colbase + 8 * gq + 4 * h, (f32x4){acc0[4 * gq], acc0[4 * gq + 1], acc0[4 * gq + 2], acc0[4 * gq + 3]});
            if (NB == 2) {
#pragma unroll
                for (int gq = 0; gq < 4; ++gq) ss += f.apply(rs, row, colbase + 32 + 8 * gq + 4 * h, (f32x4){acc1[4 * gq], acc1[4 * gq + 1], acc1[4 * gq + 2], acc1[4 * gq + 3]});
            }
        }
        if (F::STATS) { ss += __shfl_xor(ss, 32); if (h == 0) f.st[(size_t)row * SS + tc] = ss; }
    }
}

__device__ __forceinline__ float log_sigmoid_fast(float z) { return fminf(z, 0.f) - 0.6931471805599453f * __builtin_amdgcn_logf(1.0f + __builtin_amdgcn_exp2f(fabsf(z) * -1.4426950408889634f)); }
__device__ __forceinline__ void flogit_rows(const Ctx& c, int l, int gw, int ngw, int lane, int nsS) {
    asm volatile("" : "+v"(lane));
    const bf16* xb = (const bf16*)(c.ws + WS_XB); const Lw w = layer_w(c, l);
    for (int row = MP + gw; row < MT; row += ngw) {
        const bf16* xp = xb + (size_t)row * D + 8 * lane; const bf16* wp = w.wf + 8 * lane;
        float a0 = 0.f, a1 = 0.f, a2 = 0.f, a3 = 0.f, a4 = 0.f, a5 = 0.f, a6 = 0.f, a7 = 0.f;
#pragma unroll
        for (int j = 0; j < 4; ++j) {
            const u32x4 xv = *(const u32x4*)(xp + 512 * j);
            const float x0 = bflo(xv.x), x1 = bfhi(xv.x), x2 = bflo(xv.y), x3 = bfhi(xv.y), x4 = bflo(xv.z), x5 = bfhi(xv.z), x6 = bflo(xv.w), x7 = bfhi(xv.w);
#define FL_DOT(a, h) { const u32x4 wv = *(const u32x4*)(wp + (size_t)(h) * D + 512 * j); \
            a += (x0 * bflo(wv.x) + x1 * bfhi(wv.x)) + (x2 * bflo(wv.y) + x3 * bfhi(wv.y)) + (x4 * bflo(wv.z) + x5 * bfhi(wv.z)) + (x6 * bflo(wv.w) + x7 * bfhi(wv.w)); }
            FL_DOT(a0, 0) FL_DOT(a1, 1) FL_DOT(a2, 2) FL_DOT(a3, 3) FL_DOT(a4, 4) FL_DOT(a5, 5) FL_DOT(a6, 6) FL_DOT(a7, 7)
#undef FL_DOT
        }
#define FL_RED(a) { a += __shfl_xor(a, 32); a += __shfl_xor(a, 16); a += __shfl_xor(a, 8); a += __shfl_xor(a, 4); a += __shfl_xor(a, 2); a += __shfl_xor(a, 1); }
        FL_RED(a0) FL_RED(a1) FL_RED(a2) FL_RED(a3) FL_RED(a4) FL_RED(a5) FL_RED(a6) FL_RED(a7)
#undef FL_RED
        float v = a0; v = lane == 1 ? a1 : v; v = lane == 2 ? a2 : v; v = lane == 3 ? a3 : v; v = lane == 4 ? a4 : v; v = lane == 5 ? a5 : v; v = lane == 6 ? a6 : v; v = lane == 7 ? a7 : v;
        const float rs = row_rs(stat_ptr(c, ST_X), row, nsS, 1.0f / D);
        if (lane < NH) c.out[O_LFS + ((size_t)l * MS + (row - MP)) * NH + lane] = log_sigmoid_fast(rs * v + c.in[11][l * NH + lane]);
    }
}

__device__ __forceinline__ void qknorm_rows(const Ctx& c, int l, int gw, int ngw, int lane) {
    asm volatile("" : "+v"(lane));
    bf16* qb = (bf16*)(c.ws + WS_QB); bf16* kb = (bf16*)(c.ws + WS_KB);
    float* kP = c.out + O_KP + (size_t)l * MP * AW; float* kS = c.out + O_KS + (size_t)l * MS * AW;
    const float* gq = c.in[12] + l * HD; const float* gk = c.in[13] + l * HD; const int d0 = (16 * lane) & 127;
    for (int row = MP + gw; row < MT; row += ngw) {
        bf16* qp = qb + (size_t)row * AW + 16 * lane; float q[16];
        { const u32x4 w0 = *(const u32x4*)qp, w1 = *(const u32x4*)(qp + 8);
          q[0] = bflo(w0.x); q[1] = bfhi(w0.x); q[2] = bflo(w0.y); q[3] = bfhi(w0.y); q[4] = bflo(w0.z); q[5] = bfhi(w0.z); q[6] = bflo(w0.w); q[7] = bfhi(w0.w);
          q[8] = bflo(w1.x); q[9] = bfhi(w1.x); q[10] = bflo(w1.y); q[11] = bfhi(w1.y); q[12] = bflo(w1.z); q[13] = bfhi(w1.z); q[14] = bflo(w1.w); q[15] = bfhi(w1.w); }
        float ss = 0.f;
#pragma unroll
        for (int e = 0; e < 16; ++e) ss += q[e] * q[e];
        ss += __shfl_xor(ss, 1); ss += __shfl_xor(ss, 2); ss += __shfl_xor(ss, 4);
        float sc = rsqrtf(ss * (1.0f / HD) + EPS) * QSCALE;
#pragma unroll
        for (int e = 0; e < 16; ++e) q[e] *= sc * gq[d0 + e];
        { u32x4 o0, o1; o0.x = cvtpk(q[0], q[1]); o0.y = cvtpk(q[2], q[3]); o0.z = cvtpk(q[4], q[5]); o0.w = cvtpk(q[6], q[7]); o1.x = cvtpk(q[8], q[9]); o1.y = cvtpk(q[10], q[11]); o1.z = cvtpk(q[12], q[13]); o1.w = cvtpk(q[14], q[15]);
          *(u32x4*)qp = o0; *(u32x4*)(qp + 8) = o1; }
        float* kp = (row < MP ? kP + (size_t)row * AW : kS + (size_t)(row - MP) * AW) + 16 * lane; float k[16];
#pragma unroll
        for (int j = 0; j < 4; ++j) { const f32x4 v = *(const f32x4*)(kp + 4 * j); k[4 * j] = v.x; k[4 * j + 1] = v.y; k[4 * j + 2] = v.z; k[4 * j + 3] = v.w; }
        ss = 0.f;
#pragma unroll
        for (int e = 0; e < 16; ++e) ss += k[e] * k[e];
        ss += __shfl_xor(ss, 1); ss += __shfl_xor(ss, 2); ss += __shfl_xor(ss, 4);
        sc = rsqrtf(ss * (1.0f / HD) + EPS);
#pragma unroll
        for (int e = 0; e < 16; ++e) k[e] *= sc * gk[d0 + e];
#pragma unroll
        for (int j = 0; j < 4; ++j) *(f32x4*)(kp + 4 * j) = (f32x4){k[4 * j], k[4 * j + 1], k[4 * j + 2], k[4 * j + 3]};
        { bf16* kbp = kb + (size_t)row * AW + 16 * lane; u32x4 o0, o1; o0.x = cvtpk(k[0], k[1]); o0.y = cvtpk(k[2], k[3]); o0.z = cvtpk(k[4], k[5]); o0.w = cvtpk(k[6], k[7]); o1.x = cvtpk(k[8], k[9]); o1.y = cvtpk(k[10], k[11]); o1.z = cvtpk(k[12], k[13]); o1.w = cvtpk(k[14], k[15]);
          *(u32x4*)kbp = o0; *(u32x4*)(kbp + 8) = o1; }
    }
}

__device__ __forceinline__ void cumsum_simple(const Ctx& c, int l, int gw, int ngw, int lane) {
    asm volatile("" : "+v"(lane));
    float* cumP = (float*)(c.ws + WS_CUM); float* cumS = cumP + (size_t)MP * NH;
    const float* lfP = c.out + O_LFP + (size_t)l * MP * NH; const float* lfS = c.out + O_LFS + (size_t)l * MS * NH; const float* cl = c.in[4] + (size_t)l * DBAT * PAST * NH;
    for (int it = gw; it < NBAT * NH + DBAT * NH; it += ngw) {
        const bool smp = it >= NBAT * NH; const int i2 = smp ? it - NBAT * NH : it, b = i2 >> 3, h = i2 & 7, n = smp ? PAST + DSEQ : SEQ, per = (n + 63) / 64;
        float loc = 0.f;
        for (int j = 0; j < per; ++j) { const int t = lane * per + j; if (t < n) loc += smp ? (t < PAST ? cl[((size_t)b * PAST + t) * NH + h] : lfS[((size_t)b * DSEQ + (t - PAST)) * NH + h]) : lfP[((size_t)b * SEQ + t) * NH + h]; }
        float inc = loc;
#pragma unroll
        for (int o = 1; o < 64; o <<= 1) { const float v = __shfl_up(inc, o); if (lane >= o) inc += v; }
        float run = inc - loc;
        for (int j = 0; j < per; ++j) { const int t = lane * per + j; if (t < n) {
            run += smp ? (t < PAST ? cl[((size_t)b * PAST + t) * NH + h] : lfS[((size_t)b * DSEQ + (t - PAST)) * NH + h]) : lfP[((size_t)b * SEQ + t) * NH + h];
            if (smp) cumS[((size_t)b * (PAST + DSEQ) + t) * NH + h] = run * LOG2E; else cumP[((size_t)b * SEQ + t) * NH + h] = run * LOG2E; } }
    }
}
__device__ __forceinline__ void attn_simple(const Ctx& c, int l, int gw, int ngw, int lane, int row_lo = 0, int row_hi = MT) {
    asm volatile("" : "+v"(lane));
    const bf16* qb = (const bf16*)(c.ws + WS_QB); const bf16* kb = (const bf16*)(c.ws + WS_KB); const bf16* vb = (const bf16*)(c.ws + WS_VB); bf16* mg = (bf16*)(c.ws + WS_MG);
    const float* cumP = (const float*)(c.ws + WS_CUM); const float* cumS = cumP + (size_t)MP * NH; float* sta = stat_ptr(c, ST_A);
    const float* ck_ = c.in[2] + (size_t)l * DBAT * PAST * AW; const float* cv_ = c.in[3] + (size_t)l * DBAT * PAST * AW;
    for (int it = row_lo * NH + gw; it < row_hi * NH; it += ngw) {
        const int row = it >> 3, h = it & 7; const bool smp = row >= MP; const int r = row - MP;
        const int b = smp ? r >> 4 : row >> 11, pos = smp ? PAST + (r & 15) : row & 2047, nkeys = pos + 1;
        unsigned qv[64];
#pragma unroll
        for (int j = 0; j < 16; ++j) { const u32x4 w = *(const u32x4*)(qb + (size_t)row * AW + h * HD + 8 * j); qv[4 * j] = w.x; qv[4 * j + 1] = w.y; qv[4 * j + 2] = w.z; qv[4 * j + 3] = w.w; }
        const float cq = smp ? cumS[((size_t)b * (PAST + DSEQ) + pos) * NH + h] : cumP[(size_t)row * NH + h];
        float m = -1e30f, lsum = 0.f, o0 = 0.f, o1 = 0.f;
        for (int k0 = 0; k0 < nkeys; k0 += 64) {
            const int j = k0 + lane; const bool valid = j < nkeys; float s = 0.f;
            if (valid) {
                if (smp && j < PAST) { const float* kp = ck_ + ((size_t)b * PAST + j) * AW + h * HD;
#pragma unroll
                    for (int d = 0; d < 32; ++d) { const f32x4 kv = *(const f32x4*)(kp + 4 * d); s += bflo(qv[2 * d]) * kv.x + bfhi(qv[2 * d]) * kv.y + bflo(qv[2 * d + 1]) * kv.z + bfhi(qv[2 * d + 1]) * kv.w; }
                } else { const int kr = smp ? MP + b * DSEQ + (j - PAST) : (b << 11) + j; const bf16* kp = kb + (size_t)kr * AW + h * HD;
#pragma unroll
                    for (int d = 0; d < 16; ++d) { const u32x4 w = *(const u32x4*)(kp + 8 * d);
                        s += bflo(qv[4 * d]) * bflo(w.x) + bfhi(qv[4 * d]) * bfhi(w.x) + bflo(qv[4 * d + 1]) * bflo(w.y) + bfhi(qv[4 * d + 1]) * bfhi(w.y)
                           + bflo(qv[4 * d + 2]) * bflo(w.z) + bfhi(qv[4 * d + 2]) * bfhi(w.z) + bflo(qv[4 * d + 3]) * bflo(w.w) + bfhi(qv[4 * d + 3]) * bfhi(w.w); } }
                const float ck = smp ? cumS[((size_t)b * (PAST + DSEQ) + j) * NH + h] : cumP[((size_t)(b << 11) + j) * NH + h];
                s += cq - ck;
            } else s = -__builtin_inff();
            const float mn = fmaxf(m, wave_max(s)), alpha = __builtin_amdgcn_exp2f(m - mn), p = __builtin_amdgcn_exp2f(s - mn);
            lsum = lsum * alpha + wave_sum(p); o0 *= alpha; o1 *= alpha; m = mn;
            const int cnt = (nkeys - k0) < 64 ? (nkeys - k0) : 64;
            for (int jj = 0; jj < cnt; ++jj) { const float pj = __shfl(p, jj); const int jk = k0 + jj; float v0, v1;
                if (smp && jk < PAST) { const f32x2 vv = *(const f32x2*)(cv_ + ((size_t)b * PAST + jk) * AW + h * HD + 2 * lane); v0 = vv.x; v1 = vv.y; }
                else { const int kr = smp ? MP + b * DSEQ + (jk - PAST) : (b << 11) + jk; const unsigned w = *(const unsigned*)(vb + (size_t)kr * AW + h * HD + 2 * lane); v0 = bflo(w); v1 = bfhi(w); }
                o0 += pj * v0; o1 += pj * v1; }
        }
        const float inv = 1.0f / lsum; o0 *= inv; o1 *= inv;
        *(unsigned*)(mg + (size_t)row * D + h * HD + 2 * lane) = cvtpk(o0, o1);
        const float ss = wave_sum(o0 * o0 + o1 * o1); if (lane == 0) sta[(size_t)row * SS + h] = ss;
    }
}
__device__ __forceinline__ void ssm_simple(const Ctx& c, int l, int gw, int ngw, int lane) {
    asm volatile("" : "+v"(lane));
    const Lw w = layer_w(c, l); const bf16* ub = (const bf16*)(c.ws + WS_UB); bf16* gs = (bf16*)(c.ws + WS_GS);
    for (int it = gw; it < NBAT * NG + DBAT * NG; it += ngw) {
        const bool smp = it >= NBAT * NG; const int i2 = smp ? it - NBAT * NG : it, b = i2 / NG, g = i2 % NG, T = smp ? DSEQ : SEQ;
        const bf16* u = ub + (smp ? UB_S_OFF + (size_t)(b * NG + g) * DSEQ * 16 : (size_t)(b * NG + g) * SEQ * 16);
        const float abr = w.abr[g * NP + lane], abi = w.abi[g * NP + lane];
        float Br[16], Bi[16], Cr[16], Ci[16];
#pragma unroll
        for (int ch = 0; ch < 16; ++ch) { Br[ch] = bf2f(w.bcat[((size_t)g * 128 + lane) * 16 + ch]); Bi[ch] = bf2f(w.bcat[((size_t)g * 128 + 64 + lane) * 16 + ch]);
            Cr[ch] = bf2f(w.ccat[((size_t)g * 16 + ch) * 128 + lane]); Ci[ch] = bf2f(w.ccat[((size_t)g * 16 + ch) * 128 + 64 + lane]); }
        const float dsk = c.in[21][l * SW + g * 16 + (lane & 15)];
        float xr = 0.f, xi = 0.f;
        if (smp) { xr = c.in[5][(((size_t)l * DBAT + b) * NG + g) * NP + lane]; xi = c.in[6][(((size_t)l * DBAT + b) * NG + g) * NP + lane]; }
        for (int t = 0; t < T; ++t) {
            const u32x4 w0 = *(const u32x4*)(u + t * 16), w1 = *(const u32x4*)(u + t * 16 + 8);
            const float uu[16] = {bflo(w0.x), bfhi(w0.x), bflo(w0.y), bfhi(w0.y), bflo(w0.z), bfhi(w0.z), bflo(w0.w), bfhi(w0.w), bflo(w1.x), bfhi(w1.x), bflo(w1.y), bfhi(w1.y), bflo(w1.z), bfhi(w1.z), bflo(w1.w), bfhi(w1.w)};
            float bur = 0.f, bui = 0.f;
#pragma unroll
            for (int ch = 0; ch < 16; ++ch) { bur += Br[ch] * uu[ch]; bui += Bi[ch] * uu[ch]; }
            const float nxr = abr * xr - abi * xi + bur, nxi = abr * xi + abi * xr + bui; xr = nxr; xi = nxi;
            float yl = 0.f;
#pragma unroll
            for (int ch = 0; ch < 16; ++ch) { const float y = wave_sum(Cr[ch] * xr + Ci[ch] * xi); if (lane == ch) yl = y; }
            if (lane < 16) { const float y = yl + dsk * bf2f(u[t * 16 + lane]); const int row = smp ? MP + b * DSEQ + t : b * SEQ + t;
                gs[(size_t)row * SW + g * 16 + lane] = (bf16)(cvtpk(gelu_tanh_(y), 0.f) & 0xffff); }
        }
        float* sre = smp ? c.out + O_SRS + (((size_t)l * DBAT + b) * NG + g) * NP : c.out + O_SRP + (((size_t)l * NBAT + b) * NG + g) * NP;
        float* sim = smp ? c.out + O_SIS + (((size_t)l * DBAT + b) * NG + g) * NP : c.out + O_SIP + (((size_t)l * NBAT + b) * NG + g) * NP;
        sre[lane] = xr; sim[lane] = xi;
    }
}

#define XB_TMO      128
#define XB_XCNT(j)  (256  + 64 * (j))
#define XB_XSUB(j)  (1280 + 64 * (j))
#define XB_XGEN(j)  (2304 + 64 * (j))
#define XB_TOP      3328
#define XB_TOPGEN   3392
#define XCD_BAR_WORDS 3456
#define XB_SPIN_CAP (1u << 24)

__device__ __forceinline__ unsigned xb_ld(unsigned* p)              { return __hip_atomic_load(p, __ATOMIC_RELAXED, __HIP_MEMORY_SCOPE_AGENT); }
__device__ __forceinline__ unsigned xb_add(unsigned* p, unsigned v) { return __hip_atomic_fetch_add(p, v, __ATOMIC_RELAXED, __HIP_MEMORY_SCOPE_AGENT); }
__device__ __forceinline__ unsigned xb_xcc_id() { return (unsigned)__builtin_amdgcn_s_getreg((3 << 11) | 20) & 0xFu; }
#define XB_SPIN(cond, bar) do { unsigned _sp = 0; while (cond) { __builtin_amdgcn_s_sleep(1); \
    if ((++_sp & 255u) == 0u) { if (xb_ld(&(bar)[XB_TMO])) break; if (_sp > XB_SPIN_CAP) { atomicAdd(&(bar)[XB_TMO], 1u); break; } } } } while (0)

struct XcdBarrier {
    unsigned* bar; unsigned x;
    volatile LAS unsigned* st;
};

__device__ __forceinline__ XcdBarrier xcd_barrier_post(unsigned* bar, volatile LAS unsigned* st) {
    XcdBarrier b; b.bar = bar; b.x = xb_xcc_id(); b.st = st;
    if (threadIdx.x == 0) (void)xb_add(&bar[XB_XCNT(b.x)], 1u);
    return b;
}
__device__ __forceinline__ void xcd_barrier_complete(unsigned* bar, unsigned x, unsigned& nloc, unsigned& nx) {
    const unsigned G = gridDim.x * gridDim.y * gridDim.z;
    unsigned sum, cnt, mine, sp = 0u;
    for (;;) {
        sum = 0u; cnt = 0u; mine = 0u;
#pragma unroll
        for (unsigned j = 0; j < 16; ++j) { const unsigned c = xb_ld(&bar[XB_XCNT(j)]); sum += c; cnt += (c > 0u) ? 1u : 0u; mine = (j == x) ? c : mine; }
        if (sum == G) break;
        __builtin_amdgcn_s_sleep(1);
        if ((++sp & 255u) == 0u) { if (xb_ld(&bar[XB_TMO])) break; if (sp > XB_SPIN_CAP) { atomicAdd(&bar[XB_TMO], 1u); break; } }
    }
    nloc = mine > 0u ? mine : 1u; nx = cnt > 0u ? cnt : 1u;
}

__device__ __forceinline__ void xcd_barrier(const XcdBarrier& b) {
    asm volatile("s_waitcnt vmcnt(0)" ::: "memory");
    __syncthreads();
    if (threadIdx.x == 0) {
        unsigned* bar = b.bar;
        __builtin_amdgcn_s_waitcnt(0);
        unsigned nloc = b.st[0], nx = b.st[1];
        if (nloc == 0u) { xcd_barrier_complete(bar, b.x, nloc, nx); b.st[0] = nloc; b.st[1] = nx; }
        const unsigned old = xb_add(&bar[XB_XSUB(b.x)], 1u);
        const unsigned gen = old / nloc;
        if (old + 1u == (gen + 1u) * nloc) {
            __builtin_amdgcn_fence(__ATOMIC_RELEASE, "agent");
            asm volatile("s_waitcnt vmcnt(0)" ::: "memory");
            const unsigned og = xb_add(&bar[XB_TOP], 1u);
            const unsigned tg = og / nx;
            if (og + 1u == (tg + 1u) * nx) xb_add(&bar[XB_TOPGEN], 1u);
            else XB_SPIN(xb_ld(&bar[XB_TOPGEN]) == tg, bar);
            __builtin_amdgcn_fence(__ATOMIC_ACQUIRE, "agent");
            xb_add(&bar[XB_XGEN(b.x)], 1u);
            asm volatile("s_waitcnt vmcnt(0)" ::: "memory");
        } else {
            XB_SPIN(xb_ld(&bar[XB_XGEN(b.x)]) == gen, bar);
            __builtin_amdgcn_fence(__ATOMIC_ACQUIRE, "agent");
            asm volatile("s_waitcnt vmcnt(0)" ::: "memory");
        }
    }
    __syncthreads();
}


namespace pg8 {
constexpr int BM = 256, BK = 64, HALF = 128, HTB = HALF * BK * 2, STAGE_BYTES = 8 * HTB, NXCD = 8, WGM = 8;
__host__ __device__ __forceinline__ int lds_byte(int r, int c) { const int st = (r >> 4) * 2 + (c >> 5), rr = r & 15, cc = c & 31, ob = rr * 64 + cc * 2; return st * 1024 + (ob ^ (((ob >> 9) & 1) << 5)); }
__host__ __device__ __forceinline__ void stage_rc(int b, int& R, int& C) { const int st = b / 1024, sb = b % 1024, swz = sb ^ (((sb >> 9) & 1) << 5); R = (st >> 1) * 16 + swz / 64; C = (st & 1) * 32 + (swz % 64) / 2; }
struct Unit { int pm, pn; };
struct Gemm { const bf16* A; const bf16* Bt; int M, N, K; };
struct StaticOrder {
    int nM, nN, nwg, G, c;
    __host__ __device__ __forceinline__ void init(int M, int N, int G_, int c_) { nM = M / BM; nN = N / BM; nwg = nM * nN; G = G_; c = c_; }
    __host__ __device__ __forceinline__ bool next(int i, Unit& u) const {
        const long L = (long)i * G + c; if (L >= nwg) return false;
        int wgid = (int)L; { const int q = nwg / NXCD, r = nwg % NXCD, xcd = wgid % NXCD, off = wgid / NXCD; wgid = (xcd < r ? xcd * (q + 1) : r * (q + 1) + (xcd - r) * q) + off; }
        const int nig = WGM * nN, gid = wgid / nig, fm = gid * WGM, gsz = (nM - fm) < WGM ? (nM - fm) : WGM;
        u.pm = fm + ((wgid % nig) % gsz); u.pn = (wgid % nig) / gsz; return true;
    }
};
template <bool PAIR, class F>
__device__ __forceinline__ void epi256(const f32x4 (&acc)[2][2][4][2], const Unit& u, int wr, int wc, int fr, int fq, const F& f, LAS float* red, int tid, bool fill) {
    LAS float* rtab = red + 1600;
    if (F::HAS_RS && fill) { if (tid < 256) rtab[tid] = f.row_begin(u.pm * BM + tid);
        asm volatile("s_waitcnt lgkmcnt(0)" ::: "memory"); __builtin_amdgcn_s_barrier(); asm volatile("" ::: "memory"); }
    if constexpr (F::QKN) {
        if (u.pn < 8) {
            LAS float* r2 = red - 4096;
#pragma unroll
            for (int ai = 0; ai < 2; ++ai)
#pragma unroll
                for (int m = 0; m < 4; ++m) { const int rl = ai * HALF + wr * 64 + m * 16 + fr; const float rs = rtab[rl];
#pragma unroll
                    for (int bj = 0; bj < 2; ++bj) { const f32x4 a = acc[ai][bj][m][0] * rs, b = acc[ai][bj][m][1] * rs; float ss = sumsq4(a) + sumsq4(b);
                        ss += __shfl_xor(ss, 16); ss += __shfl_xor(ss, 32); if (fq == 0) r2[(rl * 2 + bj) * 4 + wc] = ss; } }
            asm volatile("s_waitcnt lgkmcnt(0)" ::: "memory"); __builtin_amdgcn_s_barrier(); asm volatile("" ::: "memory");
            const bool isq = u.pn < 4; const float* gv = isq ? f.gq : f.gk;
#pragma unroll
            for (int ai = 0; ai < 2; ++ai)
#pragma unroll
                for (int m = 0; m < 4; ++m) { const int rl = ai * HALF + wr * 64 + m * 16 + fr, row = u.pm * BM + rl; const float rs = rtab[rl];
#pragma unroll
                    for (int bj = 0; bj < 2; ++bj) { const f32x4 p4 = *(const LAS f32x4*)(r2 + (rl * 2 + bj) * 4);
                        const float sc = rs * rsqrtf(((p4.x + p4.y) + (p4.z + p4.w)) * (1.0f / HD) + EPS) * (isq ? QSCALE : 1.0f);
#pragma unroll
                        for (int n = 0; n < 2; ++n) { const int d = wc * 32 + n * 16 + 4 * fq, col = (u.pn & 3) * BM + bj * HALF + d; const f32x4 o = acc[ai][bj][m][n] * sc * *(const f32x4*)(gv + d);
                            if (isq) st_bf4(f.qb + (size_t)row * AW + col, o);
                            else { *(f32x4*)(f.kP + (size_t)row * AW + col) = o; st_bf4(f.kb + (size_t)row * AW + col, o); } } }
                    if (m & 1) asm volatile("" ::: "memory"); }
            return;
        }
    }
#pragma unroll
    for (int ai = 0; ai < 2; ++ai)
#pragma unroll
        for (int m = 0; m < 4; ++m) {
            const int rl = ai * HALF + wr * 64 + m * 16 + fr, row = u.pm * BM + rl; const float rs = F::HAS_RS ? rtab[rl] : 1.f; float ss = 0.f;
            if constexpr (PAIR) {
#pragma unroll
                for (int n = 0; n < 2; ++n) ss += f.apply2(rs, row, u.pn * HALF + wc * 32 + n * 16 + 4 * fq, acc[ai][0][m][n], acc[ai][1][m][n]);
            } else {
#pragma unroll
                for (int bj = 0; bj < 2; ++bj)
#pragma unroll
                    for (int n = 0; n < 2; ++n) ss += f.apply(rs, row, u.pn * BM + bj * HALF + wc * 32 + n * 16 + 4 * fq, acc[ai][bj][m][n]);
            }
            if (F::STATS) { ss += __shfl_xor(ss, 16); ss += __shfl_xor(ss, 32); if (fq == 0) red[rl * 4 + wc] = ss; }
            if (m == 3) asm volatile("" ::: "memory");
        }
    if (F::STATS) {
        asm volatile("s_waitcnt lgkmcnt(0)" ::: "memory"); __builtin_amdgcn_s_barrier(); asm volatile("" ::: "memory");
        if (tid < 256) { const f32x4 p = *(const LAS f32x4*)(red + tid * 4); f.st[(size_t)(u.pm * BM + tid) * SS + u.pn] = (p.x + p.y) + (p.z + p.w); }
    }
}
template <bool PAIR, class F>
__device__ __forceinline__ void gemm_phase(LAS unsigned char* lds, LAS float* red, const Gemm g, const StaticOrder& S, const F& E, int tid) {
    asm volatile("" : "+v"(tid));
    const int wid = __builtin_amdgcn_readfirstlane(tid >> 6), lane = tid & 63, wr = wid >> 2, wc = wid & 3, fr = lane & 15, fq = lane >> 4;
    const int K = g.K, nt = K / BK;
    unsigned voffA[2];
#pragma unroll
    for (int i = 0; i < 2; ++i) { int R, C; stage_rc(tid * 16 + i * 8192, R, C); voffA[i] = (unsigned)(R * K + C) * 2u; }
    const size_t kstep = (size_t)(BK * 2), hstep = (size_t)HALF * K * 2, tstep = 2 * hstep;
    const unsigned ldsw = (unsigned)wid * 1024u;
    const int aoff = lds_byte(wr * 64 + fr, fq * 8), boff = lds_byte(wc * 32 + fr, fq * 8);
#define PG8_SA(b, h) (((b) * 2 + (h)) * HTB)
#define PG8_SB(b, h) ((4 + (b) * 2 + (h)) * HTB)
#define PG8_STAGE(bufoff, gbase) do { _Pragma("unroll") for (int _i = 0; _i < 2; ++_i) \
        __builtin_amdgcn_global_load_lds((const unsigned*)((const char*)(gbase) + voffA[_i]), (LAS unsigned*)(lds + (bufoff) + ldsw + _i * 8192), 16, 0, 0); } while (0)
#define PG8_LDA(dst, b, h) do { _Pragma("unroll") for (int m = 0; m < 4; ++m) _Pragma("unroll") for (int k = 0; k < 2; ++k) dst[m][k] = *(const LAS bf16x8*)(lds + PG8_SA(b, h) + aoff + m * 2048 + k * 1024); } while (0)
#define PG8_LDB(dst, b, h) do { _Pragma("unroll") for (int n = 0; n < 2; ++n) _Pragma("unroll") for (int k = 0; k < 2; ++k) dst[n][k] = *(const LAS bf16x8*)(lds + PG8_SB(b, h) + boff + n * 2048 + k * 1024); } while (0)
#define PG8_MMA(ai, bj, At, Bt) do { __builtin_amdgcn_s_setprio(1); _Pragma("unroll") for (int m = 0; m < 4; ++m) _Pragma("unroll") for (int n = 0; n < 2; ++n) _Pragma("unroll") for (int k = 0; k < 2; ++k) \
        acc[ai][bj][m][n] = __builtin_amdgcn_mfma_f32_16x16x32_bf16(Bt[n][k], At[m][k], acc[ai][bj][m][n], 0, 0, 0); __builtin_amdgcn_s_setprio(0); } while (0)
#define PG8_WAIT_V(n) asm volatile("s_waitcnt vmcnt(" #n ")" ::: "memory")
#define PG8_WAIT_L(n) asm volatile("s_waitcnt lgkmcnt(" #n ")" ::: "memory")
#define PG8_BAR __builtin_amdgcn_s_barrier()
#define PG8_SCHED __builtin_amdgcn_sched_barrier(0)
    Unit cur, nxt; int ui = 0, rt_pm = -1;
    if (!S.next(0, cur)) return;
    f32x4 acc[2][2][4][2];
#pragma unroll
    for (int a = 0; a < 2; ++a)
#pragma unroll
        for (int b = 0; b < 2; ++b)
#pragma unroll
            for (int m = 0; m < 4; ++m)
#pragma unroll
                for (int n = 0; n < 2; ++n) acc[a][b][m][n] = (f32x4){0.f, 0.f, 0.f, 0.f};
    bf16x8 At[4][2], B0[2][2], B1[2][2];
    const char* cA = (const char*)g.A + (size_t)cur.pm * tstep; const char* cB = (const char*)g.Bt + (size_t)cur.pn * tstep;
    PG8_STAGE(PG8_SB(0, 0), cB); PG8_STAGE(PG8_SB(0, 1), cB + hstep); PG8_STAGE(PG8_SA(0, 0), cA); PG8_STAGE(PG8_SA(0, 1), cA + hstep);
    if (wr == 1) PG8_BAR;
    PG8_WAIT_V(2); PG8_BAR;
    PG8_STAGE(PG8_SB(1, 0), cB + kstep); PG8_STAGE(PG8_SA(1, 0), cA + kstep); PG8_STAGE(PG8_SB(1, 1), cB + hstep + kstep);
    PG8_WAIT_V(6); PG8_BAR;
    for (;;) {
        const bool has_next = S.next(ui + 1, nxt);
        const char* nA = has_next ? (const char*)g.A + (size_t)nxt.pm * tstep : cA; const char* nB = has_next ? (const char*)g.Bt + (size_t)nxt.pn * tstep : cB;
        for (int t = 0; t < nt; t += 2) {
            const bool last = (t == nt - 2);
            const char* a1 = cA + (size_t)(t + 1) * kstep;
            const char* a2 = last ? nA : cA + (size_t)(t + 2) * kstep; const char* b2 = last ? nB : cB + (size_t)(t + 2) * kstep;
            const char* a3 = a2 + kstep; const char* b3 = b2 + kstep;
            if constexpr (F::MID) { if (t == nt / 2) {
#pragma unroll
                for (int ai = 0; ai < 2; ++ai)
#pragma unroll
                    for (int m = 0; m < 4; ++m) { const float sc = E.mid_tab[ui * BM + ai * HALF + wr * 64 + m * 16 + fr];
#pragma unroll
                        for (int bj = 0; bj < 2; ++bj)
#pragma unroll
                            for (int n = 0; n < 2; ++n) acc[ai][bj][m][n] = acc[ai][bj][m][n] * sc; }
            } }
            PG8_LDB(B0, 0, 0); PG8_LDB(B1, 0, 1); PG8_SCHED; PG8_LDA(At, 0, 0); PG8_STAGE(PG8_SA(1, 1), a1 + hstep);
            PG8_WAIT_V(8); PG8_WAIT_L(0); PG8_BAR; PG8_MMA(0, 0, At, B0); PG8_MMA(0, 1, At, B1); PG8_BAR; PG8_SCHED;
            PG8_LDA(At, 0, 1); PG8_STAGE(PG8_SB(0, 0), b2); PG8_STAGE(PG8_SB(0, 1), b2 + hstep); PG8_STAGE(PG8_SA(0, 0), a2);
            PG8_WAIT_V(8); PG8_WAIT_L(0); PG8_BAR; PG8_MMA(1, 0, At, B0); PG8_MMA(1, 1, At, B1); PG8_BAR; PG8_SCHED;
            PG8_LDB(B0, 1, 0); PG8_LDB(B1, 1, 1); PG8_SCHED; PG8_LDA(At, 1, 0); PG8_STAGE(PG8_SA(0, 1), a2 + hstep);
            PG8_WAIT_V(8); PG8_WAIT_L(0); PG8_BAR; PG8_MMA(0, 0, At, B0); PG8_MMA(0, 1, At, B1); PG8_BAR; PG8_SCHED;
            PG8_LDA(At, 1, 1); PG8_STAGE(PG8_SB(1, 0), b3); PG8_STAGE(PG8_SB(1, 1), b3 + hstep); PG8_STAGE(PG8_SA(1, 0), a3);
            PG8_WAIT_V(8); PG8_WAIT_L(0); PG8_BAR; PG8_MMA(1, 0, At, B0); PG8_MMA(1, 1, At, B1); PG8_BAR; PG8_SCHED;
        }
        if (wr == 0) PG8_BAR;
        epi256<PAIR>(acc, cur, wr, wc, fr, fq, E, red, tid, cur.pm != rt_pm); rt_pm = cur.pm;
        if (!has_next) break;
#pragma unroll
        for (int a = 0; a < 2; ++a)
#pragma unroll
            for (int b = 0; b < 2; ++b)
#pragma unroll
                for (int m = 0; m < 4; ++m)
#pragma unroll
                    for (int n = 0; n < 2; ++n) acc[a][b][m][n] = (f32x4){0.f, 0.f, 0.f, 0.f};
        cur = nxt; cA = nA; cB = nB; ++ui;
        if (wr == 1) PG8_BAR;
    }
    PG8_WAIT_V(0);
    PG8_BAR;
#undef PG8_SA
#undef PG8_SB
#undef PG8_STAGE
#undef PG8_LDA
#undef PG8_LDB
#undef PG8_MMA
#undef PG8_WAIT_V
#undef PG8_WAIT_L
#undef PG8_BAR
#undef PG8_SCHED
}
}

namespace att {
typedef short v4i16_t __attribute__((ext_vector_type(4)));
__device__ __forceinline__ int kswz(int row, int colB) { return row * 256 + (colB ^ ((row & 7) << 4)); }
__device__ __forceinline__ s16x4 vtr(const LAS unsigned char* p) { return __builtin_bit_cast(s16x4, __builtin_amdgcn_ds_read_tr16_b64_v4i16((LAS v4i16_t*)p)); }
__device__ __forceinline__ bf16x8 pack8(const f32x16& p, int b) {
    u32x4 w; w.x = cvtpk(p[b + 0], p[b + 1]); w.y = cvtpk(p[b + 2], p[b + 3]); w.z = cvtpk(p[b + 4], p[b + 5]); w.w = cvtpk(p[b + 6], p[b + 7]); return __builtin_bit_cast(bf16x8, w);
}
struct State { f32x16 o[4]; float m, l; };
template <int NBK, int VBS, bool MASK>
__device__ __forceinline__ void tile(State& S, const bf16x8 (&qr)[8], const LAS unsigned char* Kb, const LAS unsigned char* Vb, const LAS float* ckp, float cq, int dq, int lane) {
    const int r32 = lane & 31, h2 = lane >> 5;
    f32x16 p[NBK];
#pragma unroll
    for (int nb = 0; nb < NBK; ++nb) p[nb] = (f32x16){0.f, 0.f, 0.f, 0.f, 0.f, 0.f, 0.f, 0.f, 0.f, 0.f, 0.f, 0.f, 0.f, 0.f, 0.f, 0.f};
    const int kx = (r32 & 7) << 4;
    const LAS unsigned char* kp4[4];
#pragma unroll
    for (int j = 0; j < 4; ++j) kp4[j] = Kb + r32 * 256 + ((32 * j + 16 * h2) ^ kx);
#pragma unroll
    for (int kq = 0; kq < 4; ++kq) {
        bf16x8 kf[2][NBK];
#pragma unroll
        for (int j = 0; j < 2; ++j)
#pragma unroll
            for (int nb = 0; nb < NBK; ++nb) kf[j][nb] = *(const LAS bf16x8*)(kp4[(2 * kq + j) & 3] + ((2 * kq + j) >> 2) * 128 + nb * 8192);
#pragma unroll
        for (int j = 0; j < 2; ++j)
#pragma unroll
            for (int nb = 0; nb < NBK; ++nb) p[nb] = __builtin_amdgcn_mfma_f32_32x32x16_bf16(kf[j][nb], qr[2 * kq + j], p[nb], 0, 0, 0);
        __builtin_amdgcn_sched_barrier(0);
    }
    float mx = -__builtin_inff();
#pragma unroll
    for (int nb = 0; nb < NBK; ++nb)
#pragma unroll
        for (int g = 0; g < 4; ++g) { const f32x4 ck = *(const LAS f32x4*)(ckp + nb * 32 + 8 * g + 4 * h2);
#pragma unroll
            for (int e = 0; e < 4; ++e) { float s = p[nb][4 * g + e] + (cq - ck[e]);
                if (MASK) { const int kk = nb * 32 + 8 * g + 4 * h2 + e; if (kk > dq) s = -__builtin_inff(); }
                p[nb][4 * g + e] = s; mx = fmaxf(mx, s); } }
    __builtin_amdgcn_sched_barrier(0);
    mx = fmaxf(mx, __shfl_xor(mx, 32));
    const float mn = (mx > S.m + 8.0f) ? mx : S.m;
    const float alpha = __builtin_amdgcn_exp2f(S.m - mn); const bool resc = __any(mn != S.m); S.m = mn;
    float ls = 0.f;
#pragma unroll
    for (int nb = 0; nb < NBK; ++nb)
#pragma unroll
        for (int i = 0; i < 16; ++i) { const float e = __builtin_amdgcn_exp2f(p[nb][i] - mn); p[nb][i] = e; ls += e; }
    S.l = S.l * alpha + ls;
    if (resc) {
#pragma unroll
        for (int d = 0; d < 4; ++d)
#pragma unroll
            for (int i = 0; i < 16; ++i) S.o[d][i] *= alpha; }
    bf16x8 pa[2 * NBK];
#pragma unroll
    for (int nb = 0; nb < NBK; ++nb) { pa[2 * nb] = pack8(p[nb], 0); pa[2 * nb + 1] = pack8(p[nb], 8); }
    const LAS unsigned char* vp = Vb + (4 * h2 + ((lane >> 2) & 3)) * 64 + ((lane >> 4) & 1) * 32 + (lane & 3) * 8;
    __builtin_amdgcn_sched_barrier(0);
#pragma unroll
    for (int d = 0; d < 4; ++d) {
        s16x4 lo[2 * NBK], hi[2 * NBK];
#pragma unroll
        for (int s = 0; s < 2 * NBK; ++s) { lo[s] = vtr(vp + d * VBS + s * 1024); hi[s] = vtr(vp + d * VBS + s * 1024 + 512); }
#pragma unroll
        for (int s = 0; s < 2 * NBK; ++s) { const bf16x8 vf = (bf16x8){lo[s][0], lo[s][1], lo[s][2], lo[s][3], hi[s][0], hi[s][1], hi[s][2], hi[s][3]};
            S.o[d] = __builtin_amdgcn_mfma_f32_32x32x16_bf16(vf, pa[s], S.o[d], 0, 0, 0); }
        __builtin_amdgcn_sched_barrier(0);
    }
}
template <int VBS, bool MASK>
__device__ __forceinline__ void tile_h2(State& S, const bf16x8 (&qr)[8], const LAS unsigned char* Kb, const LAS unsigned char* Vb, const LAS float* ckp, float cq, int dq, int lane) {
    const int r32 = lane & 31, h2 = lane >> 5, kx = (r32 & 7) << 4;
    const f32x16 z16 = (f32x16){0.f, 0.f, 0.f, 0.f, 0.f, 0.f, 0.f, 0.f, 0.f, 0.f, 0.f, 0.f, 0.f, 0.f, 0.f, 0.f};
    f32x16 p[2] = {z16, z16};
    const LAS unsigned char* kp4[4];
#pragma unroll
    for (int j = 0; j < 4; ++j) kp4[j] = Kb + r32 * 256 + ((32 * j + 16 * h2) ^ kx);
#pragma unroll
    for (int nb = 0; nb < 2; ++nb) {
#pragma unroll
        for (int kq = 0; kq < 2; ++kq) { bf16x8 kf[4];
#pragma unroll
            for (int j = 0; j < 4; ++j) kf[j] = *(const LAS bf16x8*)(kp4[j] + kq * 128 + nb * 8192);
#pragma unroll
            for (int j = 0; j < 4; ++j) p[nb] = __builtin_amdgcn_mfma_f32_32x32x16_bf16(kf[j], qr[4 * kq + j], p[nb], 0, 0, 0); }
    }
    const LAS unsigned char* vp = Vb + (4 * h2 + ((lane >> 2) & 3)) * 64 + ((lane >> 4) & 1) * 32 + (lane & 3) * 8;
#pragma unroll
    for (int nb = 0; nb < 2; ++nb) {
        float mx = -__builtin_inff();
#pragma unroll
        for (int g = 0; g < 4; ++g) { const f32x4 ck = *(const LAS f32x4*)(ckp + nb * 32 + 8 * g + 4 * h2);
#pragma unroll
            for (int e = 0; e < 4; ++e) { float s = p[nb][4 * g + e] + (cq - ck[e]);
                if (MASK) { const int kk = nb * 32 + 8 * g + 4 * h2 + e; if (kk > dq) s = -__builtin_inff(); }
                p[nb][4 * g + e] = s; mx = fmaxf(mx, s); } }
        mx = fmaxf(mx, __shfl_xor(mx, 32));
        const float mn = (mx > S.m + 8.0f) ? mx : S.m;
        const float alpha = __builtin_amdgcn_exp2f(S.m - mn); const bool resc = __any(mn != S.m); S.m = mn;
        float ls = 0.f;
#pragma unroll
        for (int i = 0; i < 16; ++i) { const float e = __builtin_amdgcn_exp2f(p[nb][i] - mn); p[nb][i] = e; ls += e; }
        S.l = S.l * alpha + ls;
        if (resc) {
#pragma unroll
            for (int d = 0; d < 4; ++d)
#pragma unroll
                for (int i = 0; i < 16; ++i) S.o[d][i] *= alpha; }
        const bf16x8 pa0 = pack8(p[nb], 0), pa1 = pack8(p[nb], 8);
#pragma unroll
        for (int d = 0; d < 4; ++d) {
            const s16x4 l0 = vtr(vp + d * VBS + (2 * nb) * 1024), h0 = vtr(vp + d * VBS + (2 * nb) * 1024 + 512), l1 = vtr(vp + d * VBS + (2 * nb + 1) * 1024), h1 = vtr(vp + d * VBS + (2 * nb + 1) * 1024 + 512);
            S.o[d] = __builtin_amdgcn_mfma_f32_32x32x16_bf16((bf16x8){l0[0], l0[1], l0[2], l0[3], h0[0], h0[1], h0[2], h0[3]}, pa0, S.o[d], 0, 0, 0);
            S.o[d] = __builtin_amdgcn_mfma_f32_32x32x16_bf16((bf16x8){l1[0], l1[1], l1[2], l1[3], h1[0], h1[1], h1[2], h1[3]}, pa1, S.o[d], 0, 0, 0); }
    }
}
template <int PER, class LD>
__device__ __forceinline__ void cumsum_lds(LAS float* cl, LAS float* scr, int n, int tid, const LD& ld) {
    asm volatile("" : "+v"(tid));
    const int lane = tid & 63, wave = tid >> 6; float v[PER]; float tot = 0.f;
#pragma unroll
    for (int e = 0; e < PER; ++e) { const int i = tid * PER + e; v[e] = i < n ? ld(i) : 0.f; tot += v[e]; }
    float inc = tot;
#pragma unroll
    for (int o = 1; o < 64; o <<= 1) { const float t = __builtin_bit_cast(float, __builtin_amdgcn_ds_bpermute(((lane - o) & 63) << 2, __builtin_bit_cast(int, inc))); if (lane >= o) inc += t; }
    if (lane == 63) scr[wave] = inc;
    __syncthreads();
    float base = inc - tot;
    for (int w = 0; w < wave; ++w) base += scr[w];
#pragma unroll
    for (int e = 0; e < PER; ++e) { base += v[e]; const int i = tid * PER + e; if (i < n) cl[i] = base * LOG2E; }
    __syncthreads();
}

constexpr int P_K = 0, P_V = 32768, P_VBS = 4160, P_VSZ = 4 * P_VBS, P_CL = P_V + 2 * P_VSZ, P_SCR = P_CL + 8448;
constexpr int S_TILE = 16384 + P_VSZ, S_BUF = 2 * S_TILE, S_CL = 2 * S_BUF, S_SCR = S_CL + 8448, S_ML = S_SCR + 64;

__device__ __forceinline__ void attn_phase(const Ctx& c, int l, LAS unsigned char* lds, int G, int bx, int tid) {
    asm volatile("" : "+v"(tid));
    const int lane = tid & 63, wave = __builtin_amdgcn_readfirstlane(tid >> 6), r32 = lane & 31, h2 = lane >> 5;
    const bf16* qb = (const bf16*)(c.ws + WS_QB); const bf16* kb = (const bf16*)(c.ws + WS_KB); const bf16* vb = (const bf16*)(c.ws + WS_VB); bf16* mg = (bf16*)(c.ws + WS_MG); float* sta = stat_ptr(c, ST_A);
#ifndef NO_PROMPT
    for (int item = bx; item < NBAT * NH * 4; item += G) {
        const int b = item >> 5, h = (item >> 2) & 7, pr = item & 3;
        const int nqb = pr == 1 ? 3 : pr == 2 ? 1 : 2;
        LAS float* cl = (LAS float*)(lds + P_CL); const float* lf = c.out + O_LFP + (size_t)l * MP * NH + (size_t)b * SEQ * NH + h;
        cumsum_lds<4>(cl, (LAS float*)(lds + P_SCR), SEQ, tid, [&](int i) { return lf[(size_t)i * NH]; });
        for (int half = 0; half < nqb; ++half) {
            int t_ = tid; asm volatile("" : "+v"(t_));
            const int lane = t_ & 63, r32 = lane & 31, h2 = lane >> 5;
            const int qblk = pr == 0 ? (half ? 3 : 7) : pr == 1 ? (half == 0 ? 6 : half == 1 ? 2 : 1) : pr == 2 ? 5 : (half ? 0 : 4), q0 = qblk * 256, nt = 4 * (qblk + 1), qw = q0 + wave * 32;
            const size_t qrow = (size_t)b * SEQ + qw + r32;
            bf16x8 qr[8];
#pragma unroll
            for (int ks = 0; ks < 8; ++ks) qr[ks] = *(const bf16x8*)(qb + qrow * AW + h * HD + 16 * ks + 8 * h2);
            const float cq = cl[qw + r32];
            State S;
#pragma unroll
            for (int d = 0; d < 4; ++d) S.o[d] = (f32x16){0.f, 0.f, 0.f, 0.f, 0.f, 0.f, 0.f, 0.f, 0.f, 0.f, 0.f, 0.f, 0.f, 0.f, 0.f, 0.f};
            S.m = -1e30f; S.l = 0.f;
            const int krow = 4 * wave + (lane >> 4);
            const bf16* kg = kb + ((size_t)b * SEQ + krow) * AW + h * HD + 8 * ((lane & 15) ^ (krow & 7));
            const bf16* vg = vb + ((size_t)b * SEQ + 32 * (wave & 1) + (lane >> 2)) * AW + h * HD + 32 * (wave >> 1) + 8 * (lane & 3);
            const int kdst = P_K + wave * 1024, vdst = P_V + (wave >> 1) * P_VBS + (wave & 1) * 2048;
#define ATT_STAGE(buf, k0_) do { const size_t o_ = (size_t)(k0_) * AW; \
                __builtin_amdgcn_global_load_lds((const unsigned*)(kg + o_), (LAS unsigned*)(lds + kdst + (buf) * 16384), 16, 0, 0); \
                __builtin_amdgcn_global_load_lds((const unsigned*)(kg + o_ + 32 * AW), (LAS unsigned*)(lds + kdst + (buf) * 16384 + 8192), 16, 0, 0); \
                __builtin_amdgcn_global_load_lds((const unsigned*)(vg + o_), (LAS unsigned*)(lds + vdst + (buf) * P_VSZ), 16, 0, 0); \
                __builtin_amdgcn_global_load_lds((const unsigned*)(vg + o_ + 16 * AW), (LAS unsigned*)(lds + vdst + (buf) * P_VSZ + 1024), 16, 0, 0); } while (0)
            ATT_STAGE(0, 0);
            asm volatile("s_waitcnt vmcnt(0)" ::: "memory"); __syncthreads();
            for (int t = 0; t < nt; ++t) {
                const int cur = t & 1, k0 = 64 * t;
                if (t + 1 < nt) ATT_STAGE(cur ^ 1, k0 + 64);
                if (k0 <= qw + 31) {
                    const LAS unsigned char* Kb = lds + P_K + cur * 16384; const LAS unsigned char* Vb = lds + P_V + cur * P_VSZ;
                    if (k0 + 63 > qw) tile_h2<P_VBS, true>(S, qr, Kb, Vb, cl + k0, cq, qw + r32 - k0, lane);
                    else tile_h2<P_VBS, false>(S, qr, Kb, Vb, cl + k0, cq, 0, lane);
                }
                asm volatile("s_waitcnt vmcnt(0)" ::: "memory"); __syncthreads();
            }
#undef ATT_STAGE
            const float lt = S.l + __shfl_xor(S.l, 32), inv = 1.0f / lt; float ss = 0.f;
            bf16* op = mg + qrow * D + h * HD + 4 * h2;
#pragma unroll
            for (int d = 0; d < 4; ++d)
#pragma unroll
                for (int g = 0; g < 4; ++g) { const f32x4 v = (f32x4){S.o[d][4 * g] * inv, S.o[d][4 * g + 1] * inv, S.o[d][4 * g + 2] * inv, S.o[d][4 * g + 3] * inv}; ss += sumsq4(v); st_bf4(op + 32 * d + 8 * g, v); }
            ss += __shfl_xor(ss, 32); if (h2 == 0) sta[qrow * SS + h] = ss;
        }
    }
#endif
#ifndef NO_SAMPLE
    for (int pit = bx; pit < NBAT * NH * 4; pit += G) {
        if ((pit & 3) < 2) continue;
        const int item = (pit >> 2) * 2 + (pit & 1), b = item >> 3, h = item & 7;
        LAS float* cl = (LAS float*)(lds + P_CL);
        const float* lfc = c.in[4] + ((size_t)l * DBAT + b) * PAST * NH + h; const float* lfn = c.out + O_LFS + ((size_t)l * MS + b * DSEQ) * NH + h;
        cumsum_lds<5>(cl, (LAS float*)(lds + P_SCR), PAST + DSEQ, tid, [&](int i) { return i < PAST ? lfc[(size_t)i * NH] : lfn[(size_t)(i - PAST) * NH]; });
        int t_ = tid; asm volatile("" : "+v"(t_));
        const int lane = t_ & 63, r32 = lane & 31, h2 = lane >> 5;
        const int qi = r32 & 15; const size_t qrow = (size_t)MP + b * DSEQ + qi;
        bf16x8 qr[8];
#pragma unroll
        for (int ks = 0; ks < 8; ++ks) qr[ks] = *(const bf16x8*)(qb + qrow * AW + h * HD + 16 * ks + 8 * h2);
        const float cq = cl[PAST + qi];
        State S;
#pragma unroll
        for (int d = 0; d < 4; ++d) S.o[d] = (f32x16){0.f, 0.f, 0.f, 0.f, 0.f, 0.f, 0.f, 0.f, 0.f, 0.f, 0.f, 0.f, 0.f, 0.f, 0.f, 0.f};
        S.m = -1e30f; S.l = 0.f;
        const float* kg0 = c.in[2] + (((size_t)l * DBAT + b) * PAST) * AW + h * HD; const float* vg0 = c.in[3] + (((size_t)l * DBAT + b) * PAST) * AW + h * HD;
        const bf16* kn0 = kb + ((size_t)MP + b * DSEQ) * AW + h * HD; const bf16* vn0 = vb + ((size_t)MP + b * DSEQ) * AW + h * HD;
#define SMP_LOAD(R, tn) do { int x_ = t_ - 128; asm volatile("" : "+v"(x_)); \
            _Pragma("unroll") for (int ps = 0; ps < 6; ++ps) { const int ci = x_ + 384 * ps; R[2 * ps] = (f32x4){0.f, 0.f, 0.f, 0.f}; R[2 * ps + 1] = R[2 * ps]; if (ci < 2048) { const int isv = ci >> 10, row = (ci >> 4) & 63, ch = ci & 15; \
                if ((tn) < 32) { const float* src = (isv ? vg0 : kg0) + (size_t)(64 * (tn) + row) * AW + 8 * ch; R[2 * ps] = *(const f32x4*)src; R[2 * ps + 1] = *(const f32x4*)(src + 4); } \
                else if (row < DSEQ) R[2 * ps] = __builtin_bit_cast(f32x4, *(const u32x4*)((isv ? vn0 : kn0) + (size_t)row * AW + 8 * ch)); } } } while (0)
#define SMP_WRITE(R, tn, buf) do { int x_ = t_ - 128; asm volatile("" : "+v"(x_)); \
            _Pragma("unroll") for (int ps = 0; ps < 6; ++ps) { const int ci = x_ + 384 * ps; if (ci < 2048) { const int isv = ci >> 10, row = (ci >> 4) & 63, ch = ci & 15; u32x4 w_; \
                if ((tn) < 32) { w_.x = cvtpk(R[2 * ps].x, R[2 * ps].y); w_.y = cvtpk(R[2 * ps].z, R[2 * ps].w); w_.z = cvtpk(R[2 * ps + 1].x, R[2 * ps + 1].y); w_.w = cvtpk(R[2 * ps + 1].z, R[2 * ps + 1].w); } \
                else w_ = __builtin_bit_cast(u32x4, R[2 * ps]); \
                if (isv) *(LAS u32x4*)(lds + P_V + (buf) * P_VSZ + (ch >> 2) * P_VBS + row * 64 + (ch & 3) * 16) = w_; else *(LAS u32x4*)(lds + P_K + (buf) * 16384 + kswz(row, ch * 16)) = w_; } } } while (0)
#define SMP_BAR() do { asm volatile("s_waitcnt lgkmcnt(0)" ::: "memory"); __builtin_amdgcn_s_barrier(); asm volatile("" ::: "memory"); } while (0)
        if (wave < 2) {
            SMP_BAR();
            for (int t = 0; t < 33; ++t) { const int cur = t & 1;
                const LAS unsigned char* Kb = lds + P_K + cur * 16384 + wave * 8192; const LAS unsigned char* Vb = lds + P_V + cur * P_VSZ + wave * 2048;
                if (t < 32) tile<1, P_VBS, false>(S, qr, Kb, Vb, cl + 64 * t + 32 * wave, cq, 0, lane);
                else if (wave == 0) tile<1, P_VBS, true>(S, qr, Kb, Vb, cl + PAST, cq, qi, lane);
                SMP_BAR(); }
        } else {
            f32x4 RA[12], RB[12];
            SMP_LOAD(RA, 0); SMP_WRITE(RA, 0, 0); SMP_LOAD(RA, 1); SMP_LOAD(RB, 2);
            SMP_BAR();
#define SMP_STEP(R, t) do { if ((t) + 1 < 33) SMP_WRITE(R, (t) + 1, ((t) & 1) ^ 1); if ((t) + 3 < 33) SMP_LOAD(R, (t) + 3); SMP_BAR(); } while (0)
            for (int t = 0; t < 32; t += 2) { SMP_STEP(RA, t); SMP_STEP(RB, t + 1); }
            SMP_STEP(RA, 32);
        }
        asm volatile("s_waitcnt vmcnt(0)" ::: "memory");
#undef SMP_BAR
#undef SMP_STEP
#undef SMP_LOAD
#undef SMP_WRITE
        const float lt = S.l + __shfl_xor(S.l, 32);
        LAS float* cmb = (LAS float*)lds; LAS float* ml = (LAS float*)(lds + 32768);
        int u_ = tid; asm volatile("" : "+v"(u_));
        { const int r32 = u_ & 31, h2 = (u_ >> 5) & 1;
        if (wave < 2 && r32 < 16) {
#pragma unroll
            for (int d = 0; d < 4; ++d)
#pragma unroll
                for (int g = 0; g < 4; ++g) *(LAS f32x4*)(cmb + (wave * 16 + r32) * 128 + 32 * d + 8 * g + 4 * h2) = (f32x4){S.o[d][4 * g], S.o[d][4 * g + 1], S.o[d][4 * g + 2], S.o[d][4 * g + 3]};
            if (h2 == 0) { ml[(wave * 16 + r32) * 2] = S.m; ml[(wave * 16 + r32) * 2 + 1] = lt; }
        } }
        __syncthreads();
        { const int q = u_ >> 5, d4 = (u_ & 31) * 4;
          const float m0 = ml[q * 2], m1 = ml[(16 + q) * 2], M = fmaxf(m0, m1), f0 = __builtin_amdgcn_exp2f(m0 - M), f1 = __builtin_amdgcn_exp2f(m1 - M);
          const float L = ml[q * 2 + 1] * f0 + ml[(16 + q) * 2 + 1] * f1;
          f32x4 acc = *(const LAS f32x4*)(cmb + q * 128 + d4) * f0 + *(const LAS f32x4*)(cmb + (16 + q) * 128 + d4) * f1;
          const float inv = 1.0f / L; acc = acc * inv;
          const size_t orow = (size_t)MP + b * DSEQ + q; st_bf4(mg + orow * D + h * HD + d4, acc);
          float ss = sumsq4(acc);
#pragma unroll
          for (int k = 1; k < 32; k <<= 1) ss += __builtin_bit_cast(float, __builtin_amdgcn_ds_bpermute(((u_ & 63) ^ k) << 2, __builtin_bit_cast(int, ss)));
          if ((u_ & 31) == 0) sta[orow * SS + h] = ss; }
        __syncthreads();
    }
#endif
}
}

namespace ssm {
constexpr int IMB = 6144, IMW = 2 * IMB, E_OFF = 8 * IMW;
constexpr int IM_C = 40, IM_G = 8 * IM_C, IM_P = 4 * IM_G;
struct Cx { float r0, i0, r1, i1; };
__device__ __forceinline__ float afma(float a, float b, float c) { float d; asm("v_fma_f32 %0, %1, %2, %3" : "=v"(d) : "v"(a), "v"(b), "v"(c)); return d; }
__device__ __forceinline__ float idv(float a) { return __builtin_amdgcn_fmed3f(a, a, a); }
template <bool OUT>
__device__ __forceinline__ void chunk(const bf16* ub, bf16* gs, size_t ubase0, size_t ubase1, size_t grow0, size_t grow1, int t0, int nsteps, const bf16x8 (&bfr)[4], const bf16x8 (&cfr)[4],
                                      float ar0, float ai0, float ar1, float ai1, f32x4 dsk, Cx& x, LAS unsigned char* img, int lane) {
    asm volatile("" : "+v"(lane));
    const int r32 = lane & 31, h2 = lane >> 5, quad = lane >> 4, c16 = lane & 15;
    const int bsel = (r32 >> 2) & 1, ti = (r32 & 3) + 4 * (r32 >> 3);
    const bf16* up = ub + (bsel ? ubase1 : ubase0) + (size_t)(t0 + ti) * 16 + 8 * h2;
    LAS unsigned char* wp = img + (r32 >> 3) * IM_G + (r32 & 7) * IM_C + 8 * h2;
    const LAS unsigned char* rp = img + quad * IM_G + ((lane >> 2) & 3) * IM_C + (lane & 3) * 8;
    const f32x16 z16 = (f32x16){0.f, 0.f, 0.f, 0.f, 0.f, 0.f, 0.f, 0.f, 0.f, 0.f, 0.f, 0.f, 0.f, 0.f, 0.f, 0.f};
    const float nai0 = -ai0, nai1 = -ai1;
    bf16x8 ufn = *(const bf16x8*)up;
    for (int s = 0; s < nsteps; ++s) {
        const bf16x8 uf = ufn;
        if (s + 1 < nsteps) ufn = *(const bf16x8*)(up + (size_t)(s + 1) * 256);
        u32x2 uw[2];
        if (OUT) {
            const u32x4 ufw = __builtin_bit_cast(u32x4, uf);
#pragma unroll
            for (int mb = 0; mb < 2; ++mb) { const int src = (c16 + 16 * mb + 32 * (quad >> 1)) << 2;
                const unsigned v0 = (unsigned)__builtin_amdgcn_ds_bpermute(src, (int)ufw.x), v1 = (unsigned)__builtin_amdgcn_ds_bpermute(src, (int)ufw.y);
                const unsigned v2 = (unsigned)__builtin_amdgcn_ds_bpermute(src, (int)ufw.z), v3 = (unsigned)__builtin_amdgcn_ds_bpermute(src, (int)ufw.w);
                uw[mb].x = (quad & 1) ? v2 : v0; uw[mb].y = (quad & 1) ? v3 : v1; }
        }
        f32x16 a0 = __builtin_amdgcn_mfma_f32_32x32x16_bf16(uf, bfr[0], z16, 0, 0, 0), a1 = __builtin_amdgcn_mfma_f32_32x32x16_bf16(uf, bfr[1], z16, 0, 0, 0);
        f32x16 a2 = __builtin_amdgcn_mfma_f32_32x32x16_bf16(uf, bfr[2], z16, 0, 0, 0), a3 = __builtin_amdgcn_mfma_f32_32x32x16_bf16(uf, bfr[3], z16, 0, 0, 0);
#pragma unroll
        for (int i = 0; i < 16; ++i) {
            const float n0r = afma(ar0, x.r0, afma(nai0, x.i0, idv(a0[i]))), n0i = afma(ar0, x.i0, afma(ai0, x.r0, idv(a2[i]))); x.r0 = n0r; x.i0 = n0i;
            const float n1r = afma(ar1, x.r1, afma(nai1, x.i1, idv(a1[i]))), n1i = afma(ar1, x.i1, afma(ai1, x.r1, idv(a3[i]))); x.r1 = n1r; x.i1 = n1i;
            if (OUT) { a0[i] = n0r; a2[i] = n0i; a1[i] = n1r; a3[i] = n1i; }
        }
        if (OUT) {
#pragma unroll
            for (int gq = 0; gq < 4; ++gq) { const int o = (gq >> 1) * IMB + (gq & 1) * 16;
                u32x2 w; w.x = cvtpk(a0[4 * gq], a0[4 * gq + 1]); w.y = cvtpk(a0[4 * gq + 2], a0[4 * gq + 3]); *(LAS u32x2*)(wp + o) = w;
                w.x = cvtpk(a1[4 * gq], a1[4 * gq + 1]); w.y = cvtpk(a1[4 * gq + 2], a1[4 * gq + 3]); *(LAS u32x2*)(wp + o + IM_P) = w;
                w.x = cvtpk(a2[4 * gq], a2[4 * gq + 1]); w.y = cvtpk(a2[4 * gq + 2], a2[4 * gq + 3]); *(LAS u32x2*)(wp + o + 2 * IM_P) = w;
                w.x = cvtpk(a3[4 * gq], a3[4 * gq + 1]); w.y = cvtpk(a3[4 * gq + 2], a3[4 * gq + 3]); *(LAS u32x2*)(wp + o + 3 * IM_P) = w; }
            asm volatile("s_waitcnt lgkmcnt(0)" ::: "memory");
#pragma unroll
            for (int mb = 0; mb < 2; ++mb) {
                f32x4 y = (f32x4){0.f, 0.f, 0.f, 0.f};
#pragma unroll
                for (int ks = 0; ks < 4; ++ks) { const s16x4 lo = att::vtr(rp + mb * IMB + ks * IM_P), hi = att::vtr(rp + mb * IMB + ks * IM_P + 4 * IM_C);
                    const bf16x8 xf = (bf16x8){lo[0], lo[1], lo[2], lo[3], hi[0], hi[1], hi[2], hi[3]};
                    y = __builtin_amdgcn_mfma_f32_16x16x32_bf16(cfr[ks], xf, y, 0, 0, 0); }
                const int tok = t0 + 16 * s + 4 * (2 * mb + (c16 >> 3)) + (c16 & 3); const size_t grq = ((c16 >> 2) & 1) ? grow1 : grow0;
                const float v0 = gelu_tanh_(y[0] + dsk.x * bflo(uw[mb].x)), v1 = gelu_tanh_(y[1] + dsk.y * bfhi(uw[mb].x)), v2 = gelu_tanh_(y[2] + dsk.z * bflo(uw[mb].y)), v3 = gelu_tanh_(y[3] + dsk.w * bfhi(uw[mb].y));
                u32x2 o; o.x = cvtpk(v0, v1); o.y = cvtpk(v2, v3); *(u32x2*)(gs + (grq + tok) * SW + 4 * quad) = o;
            }
            asm volatile("s_waitcnt lgkmcnt(0)" ::: "memory");
        }
    }
}
__device__ __forceinline__ void ssm_phase(const Ctx& c, int l, LAS unsigned char* lds, int G, int bx, int tid) {
    asm volatile("" : "+v"(tid));
    const int lane = tid & 63, wave = __builtin_amdgcn_readfirstlane(tid >> 6), r32 = lane & 31, h2 = lane >> 5, quad = lane >> 4, c16 = lane & 15;
    const Lw w = layer_w(c, l); const bf16* ub = (const bf16*)(c.ws + WS_UB); bf16* gs = (bf16*)(c.ws + WS_GS);
    LAS unsigned char* img = lds + wave * IMW; LAS float* E = (LAS float*)(lds + E_OFF);
    for (int item = bx; item < NG * 4 + NG; item += G) {
        const bool smp = item >= NG * 4; const int g = smp ? item - NG * 4 : item >> 2, bp = smp ? wave : item & 3, b0 = 2 * bp, T = smp ? DSEQ : SEQ;
        bf16x8 bfr[4], cfr[4];
#pragma unroll
        for (int nb = 0; nb < 4; ++nb) bfr[nb] = *(const bf16x8*)(w.bcat + ((size_t)g * 128 + 32 * nb + r32) * 16 + 8 * h2);
#pragma unroll
        for (int ks = 0; ks < 4; ++ks) cfr[ks] = *(const bf16x8*)(w.ccat + ((size_t)g * 16 + c16) * 128 + 32 * ks + 8 * quad);
        const float ar0 = w.abr[g * NP + r32], ai0 = w.abi[g * NP + r32], ar1 = w.abr[g * NP + 32 + r32], ai1 = w.abi[g * NP + 32 + r32];
        const f32x4 dsk = *(const f32x4*)(c.in[21] + l * SW + g * 16 + 4 * quad);
        const size_t ub0 = (smp ? UB_S_OFF : 0) + ((size_t)b0 * NG + g) * T * 16, ub1 = ub0 + (size_t)NG * T * 16;
        const size_t gr0 = smp ? (size_t)MP + b0 * DSEQ : (size_t)b0 * SEQ, gr1 = gr0 + T;
        bf16* gsg = gs + g * 16;
        Cx x; x.r0 = 0.f; x.i0 = 0.f; x.r1 = 0.f; x.i1 = 0.f;
        if (!smp) {
            chunk<false>(ub, gsg, ub0, ub1, gr0, gr1, wave * 256, 16, bfr, cfr, ar0, ai0, ar1, ai1, dsk, x, img, lane);
            E[(wave * 4 + 0) * 64 + lane] = x.r0; E[(wave * 4 + 1) * 64 + lane] = x.i0; E[(wave * 4 + 2) * 64 + lane] = x.r1; E[(wave * 4 + 3) * 64 + lane] = x.i1;
            __syncthreads();
            float p0r = ar0, p0i = ai0, p1r = ar1, p1i = ai1;
#pragma unroll
            for (int k = 0; k < 8; ++k) { const float t0r = p0r * p0r - p0i * p0i, t0i = (p0r + p0r) * p0i, t1r = p1r * p1r - p1i * p1i, t1i = (p1r + p1r) * p1i; p0r = t0r; p0i = t0i; p1r = t1r; p1i = t1i; }
            x.r0 = 0.f; x.i0 = 0.f; x.r1 = 0.f; x.i1 = 0.f;
            for (int ww = 0; ww < wave; ++ww) {
                const float e0r = E[(ww * 4 + 0) * 64 + lane], e0i = E[(ww * 4 + 1) * 64 + lane], e1r = E[(ww * 4 + 2) * 64 + lane], e1i = E[(ww * 4 + 3) * 64 + lane];
                const float n0r = p0r * x.r0 - p0i * x.i0 + e0r, n0i = p0r * x.i0 + p0i * x.r0 + e0i, n1r = p1r * x.r1 - p1i * x.i1 + e1r, n1i = p1r * x.i1 + p1i * x.r1 + e1i;
                x.r0 = n0r; x.i0 = n0i; x.r1 = n1r; x.i1 = n1i; }
            chunk<true>(ub, gsg, ub0, ub1, gr0, gr1, wave * 256, 16, bfr, cfr, ar0, ai0, ar1, ai1, dsk, x, img, lane);
            __syncthreads();
        } else {
            const size_t so = (((size_t)l * DBAT + b0 + h2) * NG + g) * NP + r32;
            x.r0 = c.in[5][so]; x.i0 = c.in[6][so]; x.r1 = c.in[5][so + 32]; x.i1 = c.in[6][so + 32];
            chunk<true>(ub, gsg, ub0, ub1, gr0, gr1, 0, 1, bfr, cfr, ar0, ai0, ar1, ai1, dsk, x, img, lane);
        }
        if (smp || wave == 7) {
            float* sre = c.out + (smp ? O_SRS + (((size_t)l * DBAT + b0 + h2) * NG + g) * NP : O_SRP + (((size_t)l * NBAT + b0 + h2) * NG + g) * NP);
            float* sim = c.out + (smp ? O_SIS + (((size_t)l * DBAT + b0 + h2) * NG + g) * NP : O_SIP + (((size_t)l * NBAT + b0 + h2) * NG + g) * NP);
            sre[r32] = x.r0; sre[r32 + 32] = x.r1; sim[r32] = x.i0; sim[r32 + 32] = x.i1;
        }
    }
}
}

constexpr int SKB_STRIDE = 528, SKB_BUF = 64 * SKB_STRIDE;
template <int NB, bool PAIR, class F>
__device__ __forceinline__ void sk_gemm(LAS unsigned char* lds, const GArgs& g, const F& f, int G, int bx, int tid) {
    asm volatile("" : "+v"(tid));
    const int lane = tid & 63, wave = __builtin_amdgcn_readfirstlane(tid >> 6), r32 = lane & 31, h2 = lane >> 5, nsc = g.K / 256;
    const int scol = tid >> 3, sp = tid & 7;
    const int nunits = g.nrt * g.nct;
    __syncthreads();
    for (int u = bx; u < nunits; u += G) {
        const int tr = u / g.nct, tc = u % g.nct, row = g.r0 + 256 * tr + 32 * wave + r32;
        int nb0, nb1, colbase;
        if (PAIR) { nb0 = 256 * (tc >> 2) + 32 * (tc & 3); nb1 = nb0 + 128; colbase = 32 * tc; } else { nb0 = 32 * NB * tc; nb1 = nb0 + 32; colbase = nb0; }
        const bf16* ap = g.A + (size_t)row * g.lda + 8 * h2;
        const bf16* bg = g.Bt + (size_t)((scol < 32 ? nb0 : nb1 - 32) + scol) * g.ldb + 8 * sp;
        const bool stg = NB == 2 || scol < 32;
        LAS unsigned char* bw = lds + scol * SKB_STRIDE + sp * 16;
        const LAS unsigned char* br = lds + r32 * SKB_STRIDE + 16 * h2;
        f32x16 acc0 = {}, acc1 = {};
        bf16x8 a[16], an[16]; u32x4 bs[4], bs2[4];
#pragma unroll
        for (int i = 0; i < 4; ++i) bs[i] = stg ? *(const u32x4*)(bg + 64 * i) : (u32x4){0u, 0u, 0u, 0u};
#pragma unroll
        for (int j = 0; j < 16; ++j) a[j] = *(const bf16x8*)(ap + 16 * j);
        if (stg) {
#pragma unroll
            for (int i = 0; i < 4; ++i) *(LAS u32x4*)(bw + 128 * i) = bs[i]; }
        if (stg && nsc > 1) {
#pragma unroll
            for (int i = 0; i < 4; ++i) bs[i] = *(const u32x4*)(bg + 256 + 64 * i); }
        __syncthreads();
        const int cmid = F::MID ? g.kmid / 256 : -1;
        for (int sc = 0; sc < nsc; ++sc) {
            const int cur = sc & 1;
            if (sc + 2 < nsc && stg) {
#pragma unroll
                for (int i = 0; i < 4; ++i) bs2[i] = *(const u32x4*)(bg + 256 * (sc + 2) + 64 * i); }
            if (sc + 1 < nsc) {
#pragma unroll
                for (int j = 0; j < 16; ++j) an[j] = *(const bf16x8*)(ap + 256 * (sc + 1) + 16 * j); }
            if (F::MID && sc == cmid) { const float sm = f.mid_scale(row);
#pragma unroll
                for (int i = 0; i < 16; ++i) { acc0[i] *= sm; acc1[i] *= sm; } }
#pragma unroll
            for (int j = 0; j < 16; ++j) {
                const bf16x8 b0 = *(const LAS bf16x8*)(br + cur * SKB_BUF + 32 * j);
                acc0 = __builtin_amdgcn_mfma_f32_32x32x16_bf16(b0, a[j], acc0, 0, 0, 0);
                if (NB == 2) { const bf16x8 b1 = *(const LAS bf16x8*)(br + cur * SKB_BUF + 32 * SKB_STRIDE + 32 * j); acc1 = __builtin_amdgcn_mfma_f32_32x32x16_bf16(b1, a[j], acc1, 0, 0, 0); }
            }
            if (sc + 1 < nsc) {
                if (stg) {
#pragma unroll
                    for (int i = 0; i < 4; ++i) { *(LAS u32x4*)(bw + (cur ^ 1) * SKB_BUF + 128 * i) = bs[i]; bs[i] = bs2[i]; } }
#pragma unroll
                for (int j = 0; j < 16; ++j) a[j] = an[j]; }
            __syncthreads();
        }
        const float rs = f.row_begin(row); float ss = 0.f;
        if constexpr (PAIR) {
#pragma unroll
            for (int gq = 0; gq < 4; ++gq) ss += f.apply2(rs, row, colbase + 8 * gq + 4 * h2, (f32x4){acc0[4 * gq], acc0[4 * gq + 1], acc0[4 * gq + 2], acc0[4 * gq + 3]}, (f32x4){acc1[4 * gq], acc1[4 * gq + 1], acc1[4 * gq + 2], acc1[4 * gq + 3]});
        } else {
#pragma unroll
            for (int gq = 0; gq < 4; ++gq) ss += f.apply(rs, row, colbase + 8 * gq + 4 * h2, (f32x4){acc0[4 * gq], acc0[4 * gq + 1], acc0[4 * gq + 2], acc0[4 * gq + 3]});
            if (NB == 2) {
#pragma unroll
                for (int gq = 0; gq < 4; ++gq) ss += f.apply(rs, row, colbase + 32 + 8 * gq + 4 * h2, (f32x4){acc1[4 * gq], acc1[4 * gq + 1], acc1[4 * gq + 2], acc1[4 * gq + 3]});
            }
        }
        if (F::STATS) { ss += __shfl_xor(ss, 32); if (h2 == 0) f.st[(size_t)row * SS + tc] = ss; }
    }
}

constexpr int SQ_PITCH = 528, SQ_A = 64 * SQ_PITCH, SQ_BUF = 96 * SQ_PITCH, SQ_PP = 36;
#define SQ_BAR() asm volatile("s_waitcnt lgkmcnt(0)\n\ts_barrier" ::: "memory")
template <class F>
__device__ __forceinline__ void sq2_gemm(LAS unsigned char* lds, const GArgs& g, const F& f, int G, int bx, int tid) {
    asm volatile("" : "+v"(tid));
    const int lane = tid & 63, wave = __builtin_amdgcn_readfirstlane(tid >> 6), r32 = lane & 31, h2 = lane >> 5, rb = wave & 1, kq = wave >> 1;
    const int nsc = g.K / 256, nunits = g.nrt * g.nct;
    const int srow = tid >> 5, sp = tid & 31;
    const int cmid = F::MID ? g.kmid / 256 : -1;
    __syncthreads();
    for (int u = bx; u < nunits; u += G) {
        const int tc = u / g.nrt, rg = u % g.nrt, row0 = g.r0 + 64 * rg, nb0 = 32 * tc;
        const bf16* ag = g.A + (size_t)(row0 + srow) * g.lda + 8 * sp;
        const bf16* bg = g.Bt + (size_t)(nb0 + srow) * g.ldb + 8 * sp;
        const size_t astep = (size_t)16 * g.lda, bstep = (size_t)16 * g.ldb;
        LAS unsigned char* sw = lds + srow * SQ_PITCH + sp * 16;
        const LAS unsigned char* ar = lds + (32 * rb + r32) * SQ_PITCH + 128 * kq + 16 * h2;
        const LAS unsigned char* br = lds + SQ_A + r32 * SQ_PITCH + 128 * kq + 16 * h2;
        const int er = tid >> 3, cq = tid & 7, grow = row0 + er;
        const float rs = f.row_begin(grow);
        f32x16 acc = {};
        u32x4 s0[6], s1[6];
#define SQ_LOAD(s, c) do { _Pragma("unroll") for (int i = 0; i < 4; ++i) s[i] = *(const u32x4*)(ag + i * astep + 256 * (c)); \
                           _Pragma("unroll") for (int i = 0; i < 2; ++i) s[4 + i] = *(const u32x4*)(bg + i * bstep + 256 * (c)); } while (0)
#define SQ_STORE(s, b) do { _Pragma("unroll") for (int i = 0; i < 4; ++i) *(LAS u32x4*)(sw + (b) * SQ_BUF + i * 16 * SQ_PITCH) = s[i]; \
                            _Pragma("unroll") for (int i = 0; i < 2; ++i) *(LAS u32x4*)(sw + (b) * SQ_BUF + SQ_A + i * 16 * SQ_PITCH) = s[4 + i]; } while (0)
#define SQ_COMPUTE(b, c) do { if (F::MID && (c) == cmid) { const float sm = f.mid_scale(row0 + 32 * rb + r32); _Pragma("unroll") for (int i = 0; i < 16; ++i) acc[i] *= sm; } \
        _Pragma("unroll") for (int j = 0; j < 4; ++j) { const bf16x8 a = *(const LAS bf16x8*)(ar + (b) * SQ_BUF + 32 * j); const bf16x8 w = *(const LAS bf16x8*)(br + (b) * SQ_BUF + 32 * j); \
            acc = __builtin_amdgcn_mfma_f32_32x32x16_bf16(w, a, acc, 0, 0, 0); } } while (0)
        SQ_LOAD(s0, 0);
        if (nsc > 1) SQ_LOAD(s1, 1);
        SQ_STORE(s0, 0);
        if (nsc > 2) SQ_LOAD(s0, 2);
        SQ_BAR();
        for (int c = 0; c < nsc; c += 2) {
            SQ_COMPUTE(0, c);
            if (c + 1 < nsc) { SQ_STORE(s1, 1); if (c + 3 < nsc) SQ_LOAD(s1, c + 3); }
            SQ_BAR();
            if (c + 1 >= nsc) break;
            SQ_COMPUTE(1, c + 1);
            if (c + 2 < nsc) { SQ_STORE(s0, 0); if (c + 4 < nsc) SQ_LOAD(s0, c + 4); }
            SQ_BAR();
        }
#undef SQ_LOAD
#undef SQ_STORE
#undef SQ_COMPUTE
        LAS float* P = (LAS float*)lds;
#pragma unroll
        for (int gq = 0; gq < 4; ++gq) *(LAS f32x4*)(P + ((kq * 64 + 32 * rb + r32) * SQ_PP + 8 * gq + 4 * h2)) = (f32x4){acc[4 * gq], acc[4 * gq + 1], acc[4 * gq + 2], acc[4 * gq + 3]};
        __syncthreads();
        {
            const LAS float* pr = P + er * SQ_PP + 4 * cq;
            const f32x4 v = (*(const LAS f32x4*)pr + *(const LAS f32x4*)(pr + 64 * SQ_PP)) + (*(const LAS f32x4*)(pr + 128 * SQ_PP) + *(const LAS f32x4*)(pr + 192 * SQ_PP));
            float ss = f.apply(rs, grow, nb0 + 4 * cq, v);
            if (F::STATS) { ss += __shfl_xor(ss, 1); ss += __shfl_xor(ss, 2); ss += __shfl_xor(ss, 4); if (cq == 0) f.st[(size_t)grow * SS + tc] = ss; }
        }
        __syncthreads();
    }
}


__device__ __forceinline__ Ctx ctx_from_kernarg() {
    Ctx c{};
#if defined(__HIP_DEVICE_COMPILE__)
    typedef const __attribute__((address_space(4))) unsigned long long* kptr_t;
    kptr_t kp = (kptr_t)__builtin_amdgcn_kernarg_segment_ptr(); asm volatile("" : "+s"(kp));
#pragma unroll
    for (int i = 0; i < 34; ++i) c.in[i] = (const float*)(GAS const float*)kp[i];
    c.out = (float*)(GAS float*)kp[34]; c.ws = (unsigned char*)(GAS unsigned char*)kp[35];
#endif
    return c;
}

constexpr int CW_BAR = 4096;
constexpr int LDS_BYTES = 155648;
constexpr int RED_OFF = 147456;
constexpr int MISC_OFF = 153600;
constexpr int MTAB_OFF = 151552;
__global__ __launch_bounds__(512, 2) void mega(Ctx c0) {
    extern __shared__ __attribute__((aligned(16))) unsigned char lds_raw[];
    LAS unsigned char* lds = (LAS unsigned char*)lds_raw; LAS float* red = (LAS float*)(lds + RED_OFF);
    const int G0 = gridDim.x, bx0 = blockIdx.x, wave0 = __builtin_amdgcn_readfirstlane(threadIdx.x >> 6);
#define LANE_ID() ({ int _l; asm volatile("v_mbcnt_lo_u32_b32 %0, -1, 0\n\tv_mbcnt_hi_u32_b32 %0, -1, %0" : "=v"(_l)); _l; })
    volatile LAS unsigned* misc = (volatile LAS unsigned*)(lds + MISC_OFF);
    if (threadIdx.x < 64) misc[threadIdx.x] = 0u;
    __syncthreads();
    (void)xcd_barrier_post((unsigned*)(c0.ws + WS_CTL) + CW_BAR, misc + 8);
#define GRID_SYNC() do { GAS unsigned char* _w = (GAS unsigned char*)ctx_from_kernarg().ws; XcdBarrier _b; _b.bar = (unsigned*)((unsigned char*)_w + WS_CTL) + CW_BAR; _b.x = xb_xcc_id(); _b.st = misc + 8; xcd_barrier(_b); } while (0)
#define PHASE_CTX int bx = bx0, G = G0; asm volatile("" : "+s"(bx), "+s"(G)); const int lane = LANE_ID(), wave = wave0, tid = wave * 64 + lane, gw = bx * 8 + wave, ngw = G * 8; (void)tid; (void)gw; (void)ngw; \
    Ctx c = ctx_from_kernarg();     \
    const Lw w = layer_w(c, l); (void)w; \
    bf16* xb = (bf16*)(c.ws + WS_XB); float* hf = (float*)(c.ws + WS_HF); bf16* hb = (bf16*)(c.ws + WS_HB); bf16* pp = (bf16*)(c.ws + WS_PP); bf16* pb = (bf16*)(c.ws + WS_PB) + (size_t)l * MT * PLE; \
    bf16* qb = (bf16*)(c.ws + WS_QB); bf16* vb = (bf16*)(c.ws + WS_VB); bf16* ub = (bf16*)(c.ws + WS_UB); bf16* gs = (bf16*)(c.ws + WS_GS); bf16* mg = (bf16*)(c.ws + WS_MG); bf16* act = (bf16*)(c.ws + WS_ACT); \
    (void)xb; (void)hf; (void)hb; (void)pp; (void)pb; (void)qb; (void)vb; (void)ub; (void)gs; (void)mg; (void)act;
    { const int lane = LANE_ID(), wave = wave0; p0_prologue(c0, lds, bx0 * 8 + wave, G0 * 8, wave, lane); }
    GRID_SYNC();
#define STAG(it) (((it) == 0) == ((bx0 & 1) == 0))
    for (int l = 0; l < NL; ++l) {
        const int nsxP = l == 0 ? 1 : D / 256, nsxS = l == 0 ? 1 : D / 32;
        { PHASE_CTX EpiIn e{stat_ptr(c, ST_X), nsxP, nsxS, nullptr, qb, vb, ub, c.out + O_KP + (size_t)l * MP * AW, c.out + O_KS + (size_t)l * MS * AW, c.out + O_VP + (size_t)l * MP * AW, c.out + O_VS + (size_t)l * MS * AW, (bf16*)(c.ws + WS_KB), c.in[12] + l * HD, c.in[13] + l * HD};
          EpiF ef{stat_ptr(c, ST_X), nsxP, nsxS, nullptr, c.in[11] + l * NH, c.out + O_LFP + (size_t)l * MP * NH, c.out + O_LFS + (size_t)l * MS * NH};
          const int ord = (bx0 & 3) == 0 ? 0x24 : (bx0 & 3) == 1 ? 0x12 : (bx0 & 3) == 2 ? 0x18 : 0x09;
          for (int it = 0; it < 3; ++it) {
              const int part = (ord >> (2 * it)) & 3;
              if (part == 0) { GArgs g{xb, D, w.win, D, D, MP, 4, 4096 / 32, 0}; sq2_gemm(lds, g, e, G, bx, tid); }
              else if (part == 1) { GArgs gf{xb, D, w.wf, D, D, 0, MP / 64, 1, 0}; sq2_gemm(lds, gf, ef, G, G - 1 - bx, tid); }
              else { pg8::Gemm gg{xb, w.win, MP, 4096, D}; pg8::StaticOrder S; S.init(MP, 4096, G, bx); pg8::gemm_phase<false>(lds, red, gg, S, e, tid); }
          } }
        GRID_SYNC();
        { PHASE_CTX ssm::ssm_phase(c, l, lds, G, bx, tid); }
        { PHASE_CTX qknorm_rows(c, l, gw, ngw, lane); flogit_rows(c, l, ngw - 1 - gw, ngw, lane, nsxS); }
        GRID_SYNC();
        for (int it = 0; it < 2; ++it) {
        if (STAG(it)) { PHASE_CTX att::attn_phase(c, l, lds, G, bx, tid); __syncthreads(); }
        else { PHASE_CTX EpiGlu e{stat_ptr(c, ST_S), c.in[23] + l * SW, gs, mg};
          GArgs g{gs, SW, w.wglu, SW, SW, MP, 4, SW / 32, 0}; sq2_gemm(lds, g, e, G, bx, tid);
          pg8::Gemm gg{gs, w.wglu, MP, SW, SW}; pg8::StaticOrder S; S.init(MP, SW, G, bx); pg8::gemm_phase<false>(lds, red, gg, S, e, tid); __syncthreads(); } }
        GRID_SYNC();
        { PHASE_CTX LAS float* mtab = (LAS float*)(lds + MTAB_OFF);
          EpiOut e{stat_ptr(c, ST_H), stat_ptr(c, ST_A), stat_ptr(c, ST_S), SW / 256, SW / 32, c.in[0], c.in[1], (const bf16*)xb, hb, mtab};
          for (int it = 0; it < 2; ++it) {
          if (STAG(it)) { GArgs g{mg, D, w.wout, D, D, MP, 4, D / 32, AW}; sq2_gemm(lds, g, e, G, bx, tid); continue; }
          pg8::Gemm gg{mg, w.wout, MP, D, D}; pg8::StaticOrder S; S.init(MP, D, G, bx);
          { int t2 = tid; asm volatile("" : "+v"(t2)); for (int i = 0; i < 2; ++i) { pg8::Unit u; if (S.next(i, u) && (t2 >> 8) == i) mtab[t2] = e.mid_scale(u.pm * 256 + (t2 & 255)); } }
          __syncthreads();
          pg8::gemm_phase<false>(lds, red, gg, S, e, tid); } }
        GRID_SYNC();
        for (int it = 0; it < 2; ++it) {
        if (STAG(it)) { PHASE_CTX EpiGU e{nullptr, stat_ptr(c, ST_H), D / 256, D / 32, act};
          GArgs g{hb, D, w.wgu, D, D, MP, 1, DFF / 32, 0}; sk_gemm<2, true>(lds, g, e, G, bx, tid);
          pg8::Gemm gg{hb, w.wgu, MP, NGU, D}; pg8::StaticOrder S; S.init(MP, NGU, G, bx); pg8::gemm_phase<true>(lds, red, gg, S, e, tid); }
        else { PHASE_CTX
          EpiPP e{nullptr, pp};
          GArgs g{pb, PLE, w.wpp, PLE, PLE, MP, 1, D / 32, 0}; sk_gemm<1, false>(lds, g, e, G, (bx + G - 176) % G, tid);
          pg8::Gemm gg{pb, w.wpp, MP, D, PLE}; pg8::StaticOrder S; S.init(MP, D, G, bx); pg8::gemm_phase<false>(lds, red, gg, S, e, tid); } }
        GRID_SYNC();
        { PHASE_CTX EpiDown e{stat_ptr(c, ST_H2), hb};
          for (int it = 0; it < 2; ++it) {
              if (STAG(it)) { GArgs g{act, DFF, w.wdown, DFF, DFF, MP, 4, D / 32, 0}; sq2_gemm(lds, g, e, G, bx, tid); }
              else { pg8::Gemm gg{act, w.wdown, MP, D, DFF}; pg8::StaticOrder S; S.init(MP, D, G, bx); pg8::gemm_phase<false>(lds, red, gg, S, e, tid); } } }
        GRID_SYNC();
        { PHASE_CTX EpiPle e{stat_ptr(c, ST_X), stat_ptr(c, ST_H2), D / 256, D / 32, pp, hb, xb, c.out + O_YP, c.out + O_YS, l == NL - 1 ? 1 : 0};
          for (int it = 0; it < 2; ++it) {
              if (STAG(it)) { GArgs g{hb, D, w.wple, D, D, MP, 4, D / 32, 0}; sq2_gemm(lds, g, e, G, bx, tid); }
              else { pg8::Gemm gg{hb, w.wple, MP, D, D}; pg8::StaticOrder S; S.init(MP, D, G, bx); pg8::gemm_phase<false>(lds, red, gg, S, e, tid); } } }
        if (l + 1 < NL) GRID_SYNC();
    }
}

extern "C" void kernel_launch(void* const* d_in, const int* in_sizes, int n_in, void* d_out, int out_size, void* d_ws, size_t ws_size, hipStream_t stream) {
    if (n_in != 34 || (size_t)out_size != O_END || ws_size < WS_END) { fprintf(stderr, "kernel_launch: unexpected sizes n_in %d out %d (want %zu) ws %zu (want %zu)\n", n_in, out_size, (size_t)O_END, ws_size, (size_t)WS_END); return; }
    static int grid = 0;
    if (grid == 0) {
        int dev = 0, cus = 0, per_cu = 0;
        if (hipGetDevice(&dev) != hipSuccess || hipDeviceGetAttribute(&cus, hipDeviceAttributeMultiprocessorCount, dev) != hipSuccess) { fprintf(stderr, "kernel_launch: device query failed\n"); grid = -1; return; }
        if (hipFuncSetAttribute((const void*)mega, hipFuncAttributeMaxDynamicSharedMemorySize, LDS_BYTES) != hipSuccess) { fprintf(stderr, "kernel_launch: hipFuncSetAttribute failed\n"); grid = -1; return; }
        if (hipOccupancyMaxActiveBlocksPerMultiprocessor(&per_cu, (const void*)mega, 512, LDS_BYTES) != hipSuccess || per_cu < 1) { fprintf(stderr, "kernel_launch: occupancy query says %d blocks per CU\n", per_cu); (void)hipGetLastError(); per_cu = 1; }
        grid = cus;
    }
    if (grid < 0) return;
    (void)hipMemsetAsync((char*)d_ws + WS_CTL, 0, CTL_BYTES, stream);
    Ctx c{}; for (int i = 0; i < 34; ++i) c.in[i] = (const float*)d_in[i]; c.out = (float*)d_out; c.ws = (unsigned char*)d_ws;
    hipLaunchKernelGGL(mega, dim3(grid), dim3(512), LDS_BYTES, stream, c);
}
```
